# Optimizing an MI355X kernel written in HIP

```python
import math
import jax, jax.numpy as jnp
from jax import lax
import numpy as np

D_MODEL = 2048
BATCH = 1
SEQ = 8192
DEPTH = 4

CHUNK = 64
N_MIXERS = 4
N_CONV_LAYERS = len(range(0, DEPTH, N_MIXERS))
N_POOL_LAYERS = len(range(1, DEPTH, N_MIXERS))
N_ATT_LAYERS = len(range(2, DEPTH, N_MIXERS))
N_SSM_LAYERS = len(range(3, DEPTH, N_MIXERS))
D_FF = 4 * D_MODEL
CONV_WIDTH = 3
POOL_WINDOWS = (2, 4, 8, 16)
N_POOL_GROUPS = len(POOL_WINDOWS)
POOL_GROUP = D_MODEL // N_POOL_GROUPS
ATT_HEAD_DIM = 128
ATT_HEADS = D_MODEL // ATT_HEAD_DIM
ATT_LEFT_CHUNKS = 8
ATT_PAD = ATT_LEFT_CHUNKS * CHUNK
ATT_BAND = ATT_PAD + CHUNK
REL_CLIP = 256
MASK_VALUE = -1e30
SSM_GROUP = 16
SSM_GROUPS = D_MODEL // SSM_GROUP
SSM_STATE = 64
SSM_BLOCK = 16
SSM_N_BLOCKS = SSM_GROUPS // SSM_BLOCK
DT_MIN = 1e-3
DT_MAX = 1e-1
RMS_EPS = 1e-6

kernel_name = 'interleaved_hybrid_streaming_encoder'


def rms_norm(x, gain):
    xf = x.astype(jnp.float32)
    y = xf * lax.rsqrt(jnp.mean(xf * xf, axis=-1, keepdims=True) + RMS_EPS)
    return (y * gain.astype(jnp.float32)).astype(x.dtype)


def squared_relu_mlp(h, w1, w2):
    a = jax.nn.relu(h @ w1)
    return (a * a) @ w2


def short_conv_mixer(h, w_in, conv_w, w_out):
    b_gate, c_gate, v = jnp.split(h @ w_in, 3, axis=-1)
    u = c_gate * v
    conv = lax.conv_general_dilated(
        u, conv_w.reshape(CONV_WIDTH, 1, D_MODEL).astype(u.dtype),
        window_strides=(1,), padding=[(CONV_WIDTH - 1, 0)],
        dimension_numbers=('NWC', 'WIO', 'NWC'), feature_group_count=D_MODEL)
    return (b_gate * conv) @ w_out


def pool_mixer(h, w_in, w_group, scale):
    b, s, _ = h.shape
    u = (h @ w_in).astype(jnp.float32).reshape(b, s, N_POOL_GROUPS, POOL_GROUP)
    csum = jnp.cumsum(u, axis=1)
    pos = jnp.arange(1, s + 1, dtype=jnp.float32)
    outs = []
    for gi, w in enumerate(POOL_WINDOWS):
        c = csum[:, :, gi]
        lagged = jnp.pad(c, ((0, 0), (w, 0), (0, 0)))[:, :s]
        count = jnp.minimum(pos, float(w))[None, :, None]
        outs.append((c - lagged) / count - u[:, :, gi])
    pooled = jnp.stack(outs, axis=2).astype(h.dtype)
    y = jnp.einsum('bsgc,gcd->bsgd', pooled, w_group)
    return y.reshape(b, s, D_MODEL) * scale


def chunk_attention_mixer(h, w_qkv, q_gain, k_gain, rel_bias, w_out):
    b, s, _ = h.shape
    nc = s // CHUNK
    qkv = (h @ w_qkv).reshape(b, s, 3, ATT_HEADS, ATT_HEAD_DIM)
    q = rms_norm(qkv[:, :, 0], q_gain)
    k = rms_norm(qkv[:, :, 1], k_gain)
    v = qkv[:, :, 2]
    k_pad = jnp.pad(k, ((0, 0), (ATT_PAD, 0), (0, 0), (0, 0)))
    v_pad = jnp.pad(v, ((0, 0), (ATT_PAD, 0), (0, 0), (0, 0)))
    q_idx = jnp.arange(CHUNK)[:, None] + ATT_PAD
    k_idx = jnp.arange(ATT_BAND)[None, :]
    rel = jnp.clip(q_idx - k_idx, -REL_CLIP, REL_CLIP) + REL_CLIP
    bias = rel_bias[:, rel].astype(jnp.float32)
    q_chunks = q.reshape(b, nc, CHUNK, ATT_HEADS, ATT_HEAD_DIM).transpose(1, 0, 2, 3, 4)
    scale = ATT_HEAD_DIM ** -0.5

    def one_chunk(args):
        c, q_c = args
        start = c * CHUNK
        k_band = lax.dynamic_slice_in_dim(k_pad, start, ATT_BAND, axis=1)
        v_band = lax.dynamic_slice_in_dim(v_pad, start, ATT_BAND, axis=1)
        scores = jnp.einsum('bqhd,bkhd->bhqk', q_c, k_band).astype(jnp.float32) * scale + bias
        key_pos = start - ATT_PAD + jnp.arange(ATT_BAND)
        scores = jnp.where((key_pos >= 0)[None, None, None, :], scores, MASK_VALUE)
        probs = jax.nn.softmax(scores, axis=-1).astype(v_band.dtype)
        return jnp.einsum('bhqk,bkhd->bqhd', probs, v_band)

    out = lax.map(one_chunk, (jnp.arange(nc), q_chunks))
    out = out.transpose(1, 0, 2, 3, 4).reshape(b, s, D_MODEL)
    return out @ w_out


def _ssm_combine(left, right):
    a1, b1 = left
    a2, b2 = right
    return a1 * a2, a2 * b1 + b2


def s5_mixer(h, a_re, a_im, log_dt, b_re, b_im, c_re, c_im, d_skip, w_glu):
    b, s, _ = h.shape
    f32 = jnp.float32
    u_flat = h.astype(f32)
    lam = lax.complex(a_re.astype(f32), a_im.astype(f32))
    dt = jnp.exp(log_dt.astype(f32))[:, None]
    a_bar = jnp.exp(lam * dt)
    b_mat = lax.complex(b_re.astype(f32), b_im.astype(f32))
    b_bar = ((a_bar - 1.0) / lam)[..., None] * b_mat
    c_mat = lax.complex(c_re.astype(f32), c_im.astype(f32))

    def to_blocks(t):
        return t.reshape(SSM_N_BLOCKS, SSM_BLOCK, *t.shape[1:])

    u_blk = u_flat.reshape(b, s, SSM_N_BLOCKS, SSM_BLOCK, SSM_GROUP).transpose(2, 0, 1, 3, 4)

    def scan_block(args):
        u_b, a_b, bb_b, c_b = args
        bu = jnp.einsum('bsgc,gnc->bsgn', u_b.astype(jnp.complex64), bb_b)
        a_t = jnp.broadcast_to(a_b, bu.shape)
        _, states = lax.associative_scan(_ssm_combine, (a_t, bu), axis=1)
        return jnp.real(jnp.einsum('bsgn,gcn->bsgc', states, c_b))

    y = lax.map(scan_block, (u_blk, to_blocks(a_bar), to_blocks(b_bar), to_blocks(c_mat)))
    y = y.transpose(1, 2, 0, 3, 4).reshape(b, s, D_MODEL) + d_skip.astype(f32) * u_flat
    z = jax.nn.gelu(y).astype(h.dtype)
    val, gate = jnp.split(z @ w_glu, 2, axis=-1)
    return val * jax.nn.sigmoid(gate)


def setup_inputs(seed: int = 0) -> dict:
    key = jax.random.key(seed)
    ks = jax.random.split(key, 32)
    f32 = jnp.float32

    def nrm(k, shape, scale):
        return jax.random.normal(k, shape, f32) * scale

    nA, nB, nC, nD = N_CONV_LAYERS, N_POOL_LAYERS, N_ATT_LAYERS, N_SSM_LAYERS
    G, N = SSM_GROUPS, SSM_STATE
    inv_d = D_MODEL ** -0.5
    return {
        'x': nrm(ks[0], (BATCH, SEQ, D_MODEL), 1.0),
        'norm_mix': 1.0 + nrm(ks[1], (DEPTH, D_MODEL), 0.02),
        'norm_mlp': 1.0 + nrm(ks[2], (DEPTH, D_MODEL), 0.02),
        'mlp_w1': nrm(ks[3], (DEPTH, D_MODEL, D_FF), inv_d),
        'mlp_w2': nrm(ks[4], (DEPTH, D_FF, D_MODEL), D_FF ** -0.5),
        'conv_w_in': nrm(ks[5], (nA, D_MODEL, 3 * D_MODEL), inv_d),
        'conv_w': nrm(ks[6], (nA, CONV_WIDTH, D_MODEL), CONV_WIDTH ** -0.5),
        'conv_w_out': nrm(ks[7], (nA, D_MODEL, D_MODEL), inv_d),
        'pool_w_in': nrm(ks[8], (nB, D_MODEL, D_MODEL), inv_d),
        'pool_w_group': nrm(ks[9], (nB, N_POOL_GROUPS, POOL_GROUP, POOL_GROUP), POOL_GROUP ** -0.5),
        'pool_scale': 1.0 + nrm(ks[10], (nB, D_MODEL), 0.1),
        'att_w_qkv': nrm(ks[11], (nC, D_MODEL, 3 * D_MODEL), inv_d),
        'att_q_norm': 1.0 + nrm(ks[12], (nC, ATT_HEAD_DIM), 0.02),
        'att_k_norm': 1.0 + nrm(ks[13], (nC, ATT_HEAD_DIM), 0.02),
        'att_rel_bias': nrm(ks[14], (nC, ATT_HEADS, 2 * REL_CLIP + 1), 0.5),
        'att_w_out': nrm(ks[15], (nC, D_MODEL, D_MODEL), inv_d),
        'ssm_a_re': -0.5 + nrm(ks[16], (nD, G, N), 0.01),
        'ssm_a_im': math.pi * jnp.arange(N, dtype=f32) + nrm(ks[17], (nD, G, N), 0.01),
        'ssm_log_dt': jax.random.uniform(ks[18], (nD, G), f32, math.log(DT_MIN), math.log(DT_MAX)),
        'ssm_b_re': nrm(ks[19], (nD, G, N, SSM_GROUP), (2 * SSM_GROUP) ** -0.5),
        'ssm_b_im': nrm(ks[20], (nD, G, N, SSM_GROUP), (2 * SSM_GROUP) ** -0.5),
        'ssm_c_re': nrm(ks[21], (nD, G, SSM_GROUP, N), (2 * N) ** -0.5 * 4.0),
        'ssm_c_im': nrm(ks[22], (nD, G, SSM_GROUP, N), (2 * N) ** -0.5 * 4.0),
        'ssm_d': nrm(ks[23], (nD, D_MODEL), 1.0),
        'ssm_w_glu': nrm(ks[24], (nD, D_MODEL, 2 * D_MODEL), inv_d),
    }


def reference(x, norm_mix, norm_mlp, mlp_w1, mlp_w2, conv_w_in, conv_w, conv_w_out,
              pool_w_in, pool_w_group, pool_scale, att_w_qkv, att_q_norm, att_k_norm,
              att_rel_bias, att_w_out, ssm_a_re, ssm_a_im, ssm_log_dt, ssm_b_re, ssm_b_im,
              ssm_c_re, ssm_c_im, ssm_d, ssm_w_glu):
    for i in range(DEPTH):
        kind = i % N_MIXERS
        j = i // N_MIXERS
        h = rms_norm(x, norm_mix[i])
        if kind == 0:
            m = short_conv_mixer(h, conv_w_in[j], conv_w[j], conv_w_out[j])
        elif kind == 1:
            m = pool_mixer(h, pool_w_in[j], pool_w_group[j], pool_scale[j])
        elif kind == 2:
            m = chunk_attention_mixer(h, att_w_qkv[j], att_q_norm[j], att_k_norm[j],
                                      att_rel_bias[j], att_w_out[j])
        else:
            m = s5_mixer(h, ssm_a_re[j], ssm_a_im[j], ssm_log_dt[j], ssm_b_re[j], ssm_b_im[j],
                         ssm_c_re[j], ssm_c_im[j], ssm_d[j], ssm_w_glu[j])
        x = x + m.astype(x.dtype)
        h = rms_norm(x, norm_mlp[i])
        x = x + squared_relu_mlp(h, mlp_w1[i], mlp_w2[i]).astype(x.dtype)
    return x
```

```cpp
#include <hip/hip_runtime.h>
#include <hip/hip_cooperative_groups.h>
#include <cstdio>
#include <cstdint>
namespace cg = cooperative_groups;

#ifndef OPMASK
#define OPMASK 0xFFFF
#endif
#ifndef PROBE_LO
#define PROBE_LO 0
#define PROBE_HI 0
#endif
#ifndef MK_MULTI
#define MK_MULTI 0
#endif

namespace pg8 {
#define PG8_LAS __attribute__((address_space(3)))
typedef unsigned short bf16_t;
typedef short bf16x8 __attribute__((ext_vector_type(8)));
typedef float f32x4 __attribute__((ext_vector_type(4)));
typedef unsigned u32x4 __attribute__((ext_vector_type(4)));
constexpr int BM = 256, BK = 64, HALF = 128, HTB = HALF * BK * 2  , STAGE_BYTES = 8 * HTB, NXCD = 8, WGM = 8;

__host__ __device__ __forceinline__ int lds_byte(int r, int c) { const int st = (r >> 4) * 2 + (c >> 5), rr = r & 15, cc = c & 31, ob = rr * 64 + cc * 2; return st * 1024 + (ob ^ (((ob >> 9) & 1) << 5)); }
__host__ __device__ __forceinline__ void stage_rc(int b, int& R, int& C) { const int st = b / 1024, sb = b % 1024, swz = sb ^ (((sb >> 9) & 1) << 5); R = (st >> 1) * 16 + swz / 64; C = (st & 1) * 32 + (swz % 64) / 2; }
__host__ __device__ __forceinline__ int perm32(int rho) { const int n = rho >> 4, i = rho & 15; return 8 * (i >> 2) + 4 * n + (i & 3); }

struct Unit { int pm, pn, ord; };
struct Gemm { const bf16_t* A; const bf16_t* Bt; int M, N, K, lda, ldb, agrp; };

struct StaticOrder {
    static constexpr int nM = 8192 / BM; int nN, nwg, G, c;
    __host__ __device__ void init(int M, int N, int G_, int c_) { nN = N / BM; nwg = nM * nN; G = G_; c = c_; }
    __host__ __device__ bool next(int i, Unit& u) const {
        const long L = (long)i * G + c; if (L >= nwg) return false;
        int wgid = (int)L; { const int q = nwg / NXCD, r = nwg % NXCD, xcd = wgid % NXCD, off = wgid / NXCD; wgid = (xcd < r ? xcd * (q + 1) : r * (q + 1) + (xcd - r) * q) + off; }
        const int nig = WGM * nN, gid = wgid / nig, fm = gid * WGM, gsz = (nM - fm) < WGM ? (nM - fm) : WGM;
        u.pm = fm + ((wgid % nig) % gsz); u.pn = (wgid % nig) / gsz; u.ord = i; return true;
    }
    __device__ __forceinline__ void a_ready(const Unit&) const {}
    __device__ __forceinline__ void done(const Unit&) const {}
};

typedef float f32x2c __attribute__((ext_vector_type(2)));
typedef __bf16 bf16x2c __attribute__((ext_vector_type(2)));
__device__ __forceinline__ unsigned cvt_pk_bf16(float lo, float hi) { const f32x2c v = {lo, hi}; const bf16x2c b = __builtin_convertvector(v, bf16x2c); return __builtin_bit_cast(unsigned, b); }

template <int ACT  > struct EpiBf16 {
    static constexpr bool PERM = true, AFTER_DRAIN = false;
    bf16_t* O; int ldc; const PG8_LAS float* rst; bf16_t* vt;
    __device__ __forceinline__ void operator()(const f32x4 (&acc)[2][2][4][2], const Unit& u, int wr, int wc, int fr, int fq) const {
        const int row0 = u.pm * BM + wr * 64 + fr, col0 = u.pn * BM + wc * 32 + 8 * fq;
        const PG8_LAS float* rsl = rst + (u.ord & 3) * 256 + wr * 64 + fr;
#pragma unroll
        for (int ai = 0; ai < 2; ++ai)
#pragma unroll
            for (int m = 0; m < 4; ++m) { bf16_t* rowp = O + (size_t)(row0 + ai * HALF + m * 16) * ldc + col0; const float rsv = rsl[ai * HALF + m * 16];
#pragma unroll
                for (int bj = 0; bj < 2; ++bj) { f32x4 v0 = acc[ai][bj][m][0] * rsv, v1 = acc[ai][bj][m][1] * rsv;
                    if (ACT == 1) {
#pragma unroll
                        for (int j = 0; j < 4; ++j) { const float a = fmaxf(v0[j], 0.f), b = fmaxf(v1[j], 0.f); v0[j] = a * a; v1[j] = b * b; } }
                    u32x4 w; w.x = cvt_pk_bf16(v0[0], v0[1]); w.y = cvt_pk_bf16(v0[2], v0[3]); w.z = cvt_pk_bf16(v1[0], v1[1]); w.w = cvt_pk_bf16(v1[2], v1[3]);
                    if (vt && u.pn >= 16) {
                        bf16_t* vp = vt + ((size_t)((2 * (u.pn - 16) + bj) * 128 + wc * 32 + 8 * fq)) * 8192 + (row0 + ai * HALF + m * 16);
                        vp[0 * 8192] = (bf16_t)(w.x & 0xffffu); vp[1 * 8192] = (bf16_t)(w.x >> 16); vp[2 * 8192] = (bf16_t)(w.y & 0xffffu); vp[3 * 8192] = (bf16_t)(w.y >> 16);
                        vp[4 * 8192] = (bf16_t)(w.z & 0xffffu); vp[5 * 8192] = (bf16_t)(w.z >> 16); vp[6 * 8192] = (bf16_t)(w.w & 0xffffu); vp[7 * 8192] = (bf16_t)(w.w >> 16);
                    } else *(u32x4*)(rowp + bj * HALF) = w; } }
    }
};
struct EpiRes {
    static constexpr bool PERM = true, AFTER_DRAIN = false;
    static constexpr int ldc = 2048; const float* base; float* out; const float* scale; bf16_t* xb; unsigned* ssq;
    __device__ __forceinline__ void operator()(const f32x4 (&acc)[2][2][4][2], const Unit& u, int wr, int wc, int fr, int fq) const {
        const int row0 = u.pm * BM + wr * 64 + fr, col0 = u.pn * BM + wc * 32 + 8 * fq;
        f32x4 sv[2][2];
#pragma unroll
        for (int bj = 0; bj < 2; ++bj)
#pragma unroll
            for (int n = 0; n < 2; ++n) sv[bj][n] = scale ? *(const f32x4*)(scale + col0 + bj * HALF + n * 4) : (f32x4){1.f, 1.f, 1.f, 1.f};
#pragma unroll
        for (int ai = 0; ai < 2; ++ai)
#pragma unroll
            for (int m = 0; m < 4; ++m) { const int row = row0 + ai * HALF + m * 16; const size_t off = (size_t)row * ldc + col0; float ss = 0.f;
#pragma unroll
                for (int bj = 0; bj < 2; ++bj) { const f32x4 b0 = *(const f32x4*)(base + off + bj * HALF), b1 = *(const f32x4*)(base + off + bj * HALF + 4);
                    const f32x4 o0 = b0 + acc[ai][bj][m][0] * sv[bj][0], o1 = b1 + acc[ai][bj][m][1] * sv[bj][1];
                    *(f32x4*)(out + off + bj * HALF) = o0; *(f32x4*)(out + off + bj * HALF + 4) = o1;
                    if (xb) { u32x4 w; w.x = cvt_pk_bf16(o0[0], o0[1]); w.y = cvt_pk_bf16(o0[2], o0[3]); w.z = cvt_pk_bf16(o1[0], o1[1]); w.w = cvt_pk_bf16(o1[2], o1[3]); *(u32x4*)(xb + off + bj * HALF) = w; }
                    ss += (o0[0] * o0[0] + o0[1] * o0[1]) + (o0[2] * o0[2] + o0[3] * o0[3]) + (o1[0] * o1[0] + o1[1] * o1[1]) + (o1[2] * o1[2] + o1[3] * o1[3]); }
                if (ssq) { ss += __shfl_xor(ss, 16); ss += __shfl_xor(ss, 32); if (fq == 0) atomicAdd(ssq + row, (unsigned)(ss * 1024.f + 0.5f)); }
                asm volatile("" ::: "memory"); }
    }
};
struct EpiGlu {
    static constexpr bool PERM = true, AFTER_DRAIN = false;
    static constexpr int ldc = 2048; const float* base; float* out; bf16_t* xb; unsigned* ssq;
    __device__ __forceinline__ void operator()(const f32x4 (&acc)[2][2][4][2], const Unit& u, int wr, int wc, int fr, int fq) const {
        const int row0 = u.pm * BM + wr * 64 + fr, col0 = u.pn * HALF + wc * 32 + 8 * fq;
#pragma unroll
        for (int ai = 0; ai < 2; ++ai)
#pragma unroll
            for (int m = 0; m < 4; ++m) { const int row = row0 + ai * HALF + m * 16; const size_t off = (size_t)row * ldc + col0; float ss = 0.f;
                f32x4 o[2];
#pragma unroll
                for (int n = 0; n < 2; ++n) { const f32x4 bs = *(const f32x4*)(base + off + n * 4); const f32x4 v = acc[ai][0][m][n], gt = acc[ai][1][m][n];
#pragma unroll
                    for (int j = 0; j < 4; ++j) { o[n][j] = bs[j] + v[j] * __builtin_amdgcn_rcpf(1.f + __expf(-gt[j])); ss += o[n][j] * o[n][j]; }
                    *(f32x4*)(out + off + n * 4) = o[n]; }
                if (xb) { u32x4 w; w.x = cvt_pk_bf16(o[0][0], o[0][1]); w.y = cvt_pk_bf16(o[0][2], o[0][3]); w.z = cvt_pk_bf16(o[1][0], o[1][1]); w.w = cvt_pk_bf16(o[1][2], o[1][3]); *(u32x4*)(xb + off) = w; }
                if (ssq) { ss += __shfl_xor(ss, 16); ss += __shfl_xor(ss, 32); if (fq == 0) atomicAdd(ssq + row, (unsigned)(ss * 1024.f + 0.5f)); }
                asm volatile("" ::: "memory"); }
    }
};

template <class Epi, class Sched, bool ALIGN_EPI = false, bool SP2 = false>
__device__ __forceinline__ void gemm_phase(PG8_LAS unsigned char* lds, const Gemm g, const Sched& S, const Epi& E, const int tid_in) {
    const int tid = tid_in, wid = __builtin_amdgcn_readfirstlane(tid >> 6), lane = tid & 63, wr = wid >> 2, wc = wid & 3, fr = lane & 15, fq = lane >> 4;
    const int K = g.K, nt = K / BK;
    unsigned voffA[2], voffB[2];
#pragma unroll
    for (int i = 0; i < 2; ++i) { int R, C; stage_rc(tid * 16 + i * 8192, R, C); const int Rb = Epi::PERM ? ((R & ~31) + perm32(R & 31)) : R;
        voffA[i] = (unsigned)(R * g.lda + C) * 2u; voffB[i] = (unsigned)(Rb * g.ldb + C) * 2u; }
    const size_t kstep = (size_t)(BK * 2);
    const size_t hstepA = (size_t)HALF * g.lda * 2, hstepB = (size_t)HALF * g.ldb * 2;
    const size_t tstepA = 2 * hstepA, tstepB = 2 * hstepB;
    const unsigned ldsw = (unsigned)wid * 1024u;
    const int aoff = lds_byte(wr * 64 + fr, fq * 8), boff = lds_byte(wc * 32 + fr, fq * 8);
#define PG8_SA(b, h) (((b) * 2 + (h)) * HTB)
#define PG8_SB(b, h) ((4 + (b) * 2 + (h)) * HTB)
#define PG8_STAGE(bufoff, gbase, voff) do { _Pragma("unroll") for (int _i = 0; _i < 2; ++_i) \
        __builtin_amdgcn_global_load_lds((const unsigned*)((const char*)(gbase) + (voff)[_i]), (PG8_LAS unsigned*)(lds + (bufoff) + ldsw + _i * 8192), 16, 0, 0); } while (0)
#define PG8_LDA(dst, b, h) do { _Pragma("unroll") for (int m = 0; m < 4; ++m) _Pragma("unroll") for (int k = 0; k < 2; ++k) dst[m][k] = *(const PG8_LAS bf16x8*)(lds + PG8_SA(b, h) + aoff + m * 2048 + k * 1024); } while (0)
#define PG8_LDB(dst, b, h) do { _Pragma("unroll") for (int n = 0; n < 2; ++n) _Pragma("unroll") for (int k = 0; k < 2; ++k) dst[n][k] = *(const PG8_LAS bf16x8*)(lds + PG8_SB(b, h) + boff + n * 2048 + k * 1024); } while (0)
#define PG8_MMA(ai, bj, At, Bt) do { __builtin_amdgcn_s_setprio(1); _Pragma("unroll") for (int m = 0; m < 4; ++m) _Pragma("unroll") for (int n = 0; n < 2; ++n) _Pragma("unroll") for (int k = 0; k < 2; ++k) \
        acc[ai][bj][m][n] = __builtin_amdgcn_mfma_f32_16x16x32_bf16(Bt[n][k], At[m][k], acc[ai][bj][m][n], 0, 0, 0); __builtin_amdgcn_s_setprio(0); } while (0)
#define PG8_WAIT_V(n) asm volatile("s_waitcnt vmcnt(" #n ")" ::: "memory")
#define PG8_WAIT_L(n) asm volatile("s_waitcnt lgkmcnt(" #n ")" ::: "memory")
#define PG8_BAR __builtin_amdgcn_s_barrier()
#define PG8_SCHED __builtin_amdgcn_sched_barrier(0)
    Unit cur, nxt; int ui = 0;
    if (!S.next(0, cur)) return;
    f32x4 acc[2][2][4][2];
#pragma unroll
    for (int a = 0; a < 2; ++a)
#pragma unroll
        for (int b = 0; b < 2; ++b)
#pragma unroll
            for (int m = 0; m < 4; ++m)
#pragma unroll
                for (int n = 0; n < 2; ++n) acc[a][b][m][n] = (f32x4){0.f, 0.f, 0.f, 0.f};
    bf16x8 At[4][2], B0[2][2], B1[2][2];
    const char* cA = (const char*)g.A + (size_t)cur.pm * tstepA + (size_t)(cur.pn >> 1) * g.agrp * 2; const char* cB = (const char*)g.Bt + (size_t)cur.pn * tstepB;
    S.a_ready(cur);
    if constexpr (SP2) {
        PG8_STAGE(PG8_SB(0, 0), cB, voffB); PG8_STAGE(PG8_SB(0, 1), cB + hstepB, voffB); PG8_STAGE(PG8_SA(0, 0), cA, voffA); PG8_STAGE(PG8_SA(0, 1), cA + hstepA, voffA);
        if (wr == 1) PG8_BAR;
        PG8_WAIT_V(2); PG8_BAR;
        PG8_STAGE(PG8_SB(1, 0), cB + kstep, voffB); PG8_STAGE(PG8_SA(1, 0), cA + kstep, voffA); PG8_STAGE(PG8_SB(1, 1), cB + hstepB + kstep, voffB);
        PG8_WAIT_V(6); PG8_BAR;
    } else {
        PG8_STAGE(PG8_SB(0, 0), cB, voffB); PG8_STAGE(PG8_SA(0, 0), cA, voffA); PG8_STAGE(PG8_SB(0, 1), cB + hstepB, voffB); PG8_STAGE(PG8_SA(0, 1), cA + hstepA, voffA);
        if (wr == 1) PG8_BAR;
        PG8_WAIT_V(4); PG8_BAR;
        PG8_STAGE(PG8_SB(1, 0), cB + kstep, voffB); PG8_STAGE(PG8_SA(1, 0), cA + kstep, voffA); PG8_STAGE(PG8_SB(1, 1), cB + hstepB + kstep, voffB);
        PG8_WAIT_V(6); PG8_BAR;
    }
    for (;;) {
        const bool has_next = S.next(ui + 1, nxt);
        const char* nA = has_next ? (const char*)g.A + (size_t)nxt.pm * tstepA + (size_t)(nxt.pn >> 1) * g.agrp * 2 : cA; const char* nB = has_next ? (const char*)g.Bt + (size_t)nxt.pn * tstepB : cB;
        for (int t = 0; t < nt; t += 2) {
            const bool last = (t == nt - 2);
            const char* a1 = cA + (size_t)(t + 1) * kstep;
            const char* a2 = last ? nA : cA + (size_t)(t + 2) * kstep; const char* b2 = last ? nB : cB + (size_t)(t + 2) * kstep;
            const char* a3 = a2 + kstep; const char* b3 = b2 + kstep;
            if (last && has_next) S.a_ready(nxt);
            if constexpr (SP2) {
            PG8_LDB(B0, 0, 0); PG8_LDB(B1, 0, 1); PG8_SCHED; PG8_LDA(At, 0, 0); PG8_STAGE(PG8_SA(1, 1), a1 + hstepA, voffA);
            PG8_WAIT_V(8); PG8_WAIT_L(0); PG8_BAR; PG8_MMA(0, 0, At, B0); PG8_MMA(0, 1, At, B1); PG8_BAR; PG8_SCHED;
            PG8_LDA(At, 0, 1); PG8_STAGE(PG8_SB(0, 0), b2, voffB); PG8_STAGE(PG8_SB(0, 1), b2 + hstepB, voffB); PG8_STAGE(PG8_SA(0, 0), a2, voffA);
            PG8_WAIT_V(8); PG8_WAIT_L(0); PG8_BAR; PG8_MMA(1, 0, At, B0); PG8_MMA(1, 1, At, B1); PG8_BAR; PG8_SCHED;
            PG8_LDB(B0, 1, 0); PG8_LDB(B1, 1, 1); PG8_SCHED; PG8_LDA(At, 1, 0); PG8_STAGE(PG8_SA(0, 1), a2 + hstepA, voffA);
            PG8_WAIT_V(8); PG8_WAIT_L(0); PG8_BAR; PG8_MMA(0, 0, At, B0); PG8_MMA(0, 1, At, B1); PG8_BAR; PG8_SCHED;
            PG8_LDA(At, 1, 1); PG8_STAGE(PG8_SB(1, 0), b3, voffB); PG8_STAGE(PG8_SB(1, 1), b3 + hstepB, voffB); PG8_STAGE(PG8_SA(1, 0), a3, voffA);
            PG8_WAIT_V(8); PG8_WAIT_L(0); PG8_BAR; PG8_MMA(1, 0, At, B0); PG8_MMA(1, 1, At, B1); PG8_BAR; PG8_SCHED;
            } else {
            PG8_LDB(B0, 0, 0); PG8_SCHED; PG8_LDA(At, 0, 0); PG8_STAGE(PG8_SA(1, 1), a1 + hstepA, voffA);
            PG8_WAIT_L(8); PG8_BAR; PG8_WAIT_L(0); PG8_MMA(0, 0, At, B0); PG8_BAR; PG8_SCHED;
            PG8_LDB(B1, 0, 1); PG8_STAGE(PG8_SB(0, 0), b2, voffB);
            PG8_BAR; PG8_WAIT_L(0); PG8_MMA(0, 1, At, B1); PG8_BAR;
            PG8_LDA(At, 0, 1); PG8_STAGE(PG8_SA(0, 0), a2, voffA);
            PG8_BAR; PG8_WAIT_L(0); PG8_MMA(1, 0, At, B0); PG8_BAR; PG8_SCHED;
            PG8_STAGE(PG8_SB(0, 1), b2 + hstepB, voffB);
            PG8_WAIT_V(6); PG8_BAR; PG8_MMA(1, 1, At, B1); PG8_BAR;
            PG8_LDB(B0, 1, 0); PG8_SCHED; PG8_LDA(At, 1, 0); PG8_STAGE(PG8_SA(0, 1), a2 + hstepA, voffA);
            PG8_WAIT_L(8); PG8_BAR; PG8_WAIT_L(0); PG8_MMA(0, 0, At, B0); PG8_BAR; PG8_SCHED;
            PG8_LDB(B1, 1, 1); PG8_STAGE(PG8_SB(1, 0), b3, voffB);
            PG8_BAR; PG8_WAIT_L(0); PG8_MMA(0, 1, At, B1); PG8_BAR;
            PG8_LDA(At, 1, 1); PG8_STAGE(PG8_SA(1, 0), a3, voffA);
            PG8_BAR; PG8_WAIT_L(0); PG8_MMA(1, 0, At, B0); PG8_BAR; PG8_SCHED;
            PG8_STAGE(PG8_SB(1, 1), b3 + hstepB, voffB);
            PG8_WAIT_V(6); PG8_BAR; PG8_MMA(1, 1, At, B1); PG8_BAR;
            }
        }
        if constexpr (ALIGN_EPI) { if (wr == 0) PG8_BAR; }
        asm volatile("s_nop 7\n\ts_nop 7\n\ts_nop 7" ::: "memory");
        if constexpr (!Epi::AFTER_DRAIN) { E(acc, cur, wr, wc, fr, fq); S.done(cur); }
        if (!has_next) break;
#pragma unroll
        for (int a = 0; a < 2; ++a)
#pragma unroll
            for (int b = 0; b < 2; ++b)
#pragma unroll
                for (int m = 0; m < 4; ++m)
#pragma unroll
                    for (int n = 0; n < 2; ++n) acc[a][b][m][n] = (f32x4){0.f, 0.f, 0.f, 0.f};
        cur = nxt; cA = nA; cB = nB; ++ui;
        if constexpr (ALIGN_EPI) { if (wr == 1) PG8_BAR; }
    }
    PG8_WAIT_V(0);
    if constexpr (!ALIGN_EPI) { if (wr == 0) PG8_BAR; }
    PG8_BAR;
    if constexpr (Epi::AFTER_DRAIN) { E.fused(acc, cur, wr, wc, fr, fq, lds, wid, lane); S.done(cur); }
#undef PG8_SA
#undef PG8_SB
#undef PG8_STAGE
#undef PG8_LDA
#undef PG8_LDB
#undef PG8_MMA
#undef PG8_WAIT_V
#undef PG8_WAIT_L
#undef PG8_BAR
#undef PG8_SCHED
}
}

constexpr int S = 8192, D = 2048, FF = 8192, NQKV = 6144;
constexpr int NPH = 21;
constexpr float RMS_EPS = 1e-6f;
constexpr float LOG2E = 1.4426950408889634f;
constexpr float ATT_QSCALE = 0.08838834764831845f * LOG2E;

constexpr size_t MiB = 1u << 20;
constexpr size_t WS_CTL = 0, CTL_ZERO_BYTES = 65536;
constexpr size_t WS_W1T = 2 * MiB;
constexpr size_t WS_W2T = 130 * MiB;
constexpr size_t WS_CINT = 258 * MiB;
constexpr size_t WS_COUTT = 282 * MiB;
constexpr size_t WS_PINT = 290 * MiB;
constexpr size_t WS_PGT = 298 * MiB;
constexpr size_t WS_QKVT = 300 * MiB;
constexpr size_t WS_AOUTT = 324 * MiB;
constexpr size_t WS_GLUT = 332 * MiB;
constexpr size_t WS_ABAR = 348 * MiB;
constexpr size_t WS_BBAR = 349 * MiB;
constexpr size_t WS_F = 350 * MiB;
constexpr size_t WS_H = 358 * MiB;
constexpr size_t WS_BIG = 390 * MiB;
constexpr size_t WS_BCV = 518 * MiB;
constexpr size_t WS_G = 614 * MiB;
constexpr size_t WS_U = 646 * MiB;
constexpr size_t WS_VT = 678 * MiB;
constexpr size_t WS_DUMMY = 710 * MiB;
constexpr size_t WS_KT = 774 * MiB;
constexpr size_t WS_SSQ = 778 * MiB;
constexpr size_t WS_END = 779 * MiB;

constexpr int LDS_BYTES = 147456, LDS_BARST = 147456 - 64;

#define LAS __attribute__((address_space(3)))
#define DI __device__ __forceinline__
typedef unsigned short bf16;
typedef float f32x4 __attribute__((ext_vector_type(4)));
typedef float f32x2 __attribute__((ext_vector_type(2)));
typedef short bf16x8 __attribute__((ext_vector_type(8)));
typedef unsigned u32x4 __attribute__((ext_vector_type(4)));
typedef unsigned u32x2 __attribute__((ext_vector_type(2)));
#define LDS_WAIT() asm volatile("s_waitcnt lgkmcnt(0)" ::: "memory")
#define MFMA_SETTLE() asm volatile("s_nop 7\n\ts_nop 7\n\ts_nop 7" ::: "memory")
using pg8::cvt_pk_bf16;
DI float bf_lo(unsigned w) { return __uint_as_float(w << 16); }
DI float bf_hi(unsigned w) { return __uint_as_float(w & 0xffff0000u); }
DI float wave_sum(float v) {
#pragma unroll
    for (int o = 1; o < 64; o <<= 1) v += __shfl_xor(v, o);
    return v;
}

DI void transpose_item(const float* W, int K, int N, bf16* WT, int mode, const float* gain, LAS float* scr, int item, int lane) {
    const int nblk = N / 64, kb = item / nblk, nb = item % nblk, k0 = 64 * kb, n0 = 64 * nb;
    const int lk = lane >> 4, ln = (lane & 15) * 4;
#pragma unroll 8
    for (int i = 0; i < 16; ++i) { const int kk = 4 * i + lk; f32x4 v = __builtin_nontemporal_load((const f32x4*)(W + (size_t)(k0 + kk) * N + n0 + ln));
        if (gain) v = v * gain[k0 + kk];
        LAS float* d = scr + kk * 65 + ln; d[0] = v.x; d[1] = v.y; d[2] = v.z; d[3] = v.w; }
    LDS_WAIT(); asm volatile("" ::: "memory");
    int r0 = n0; if (mode == 1) { const int ch = n0 & 2047, half = n0 >> 11; r0 = 256 * (ch >> 7) + 128 * half + (ch & 127); }
    const int c = lane >> 3;
#pragma unroll
    for (int j = 0; j < 8; ++j) { const int n = (lane & 7) + 8 * j; const LAS float* s = scr + (8 * c) * 65 + n;
        u32x4 o; o.x = cvt_pk_bf16(s[0 * 65], s[1 * 65]); o.y = cvt_pk_bf16(s[2 * 65], s[3 * 65]); o.z = cvt_pk_bf16(s[4 * 65], s[5 * 65]); o.w = cvt_pk_bf16(s[6 * 65], s[7 * 65]);
        *(u32x4*)(WT + (size_t)(r0 + n) * K + k0 + 8 * c) = o; }
    LDS_WAIT(); asm volatile("" ::: "memory");
}

DI void xb_rows(const float* x, bf16* H, unsigned* ssq, int gw, int NGW, int lane) {
    for (int row = gw; row < S; row += NGW) {
        const float* xr = x + (size_t)row * D + lane * 8;
        bf16* hr = H + (size_t)row * D + lane * 8;
        float s = 0.f;
#pragma unroll
        for (int j = 0; j < 4; ++j) { const f32x4 a = *(const f32x4*)(xr + j * 512), b = *(const f32x4*)(xr + j * 512 + 4);
            s += (a.x * a.x + a.y * a.y) + (a.z * a.z + a.w * a.w) + (b.x * b.x + b.y * b.y) + (b.z * b.z + b.w * b.w);
            u32x4 o; o.x = cvt_pk_bf16(a.x, a.y); o.y = cvt_pk_bf16(a.z, a.w); o.z = cvt_pk_bf16(b.x, b.y); o.w = cvt_pk_bf16(b.z, b.w);
            *(u32x4*)(hr + j * 512) = o; }
        s = wave_sum(s);
        if (lane == 0) ssq[row] = (unsigned)(s * 1024.f + 0.5f);
    }
}

DI void ssm_ktab(const float* a_re, const float* a_im, const float* log_dt, const float* b_re, const float* b_im, const float* c_re, const float* c_im, unsigned short* Kt, LAS float* scr, int lane, int gw, int NGW);
DI void ssm_coef(const float* a_re, const float* a_im, const float* log_dt, int g, int n, f32x2& abar, f32x2& coef);
struct Args { const float* in[25]; float* out; unsigned char* ws; int ph_lo, ph_hi; };
typedef __attribute__((address_space(4))) const Args CArgs;

DI void prologue(CArgs* a, LAS unsigned char* lds, int wave, int lane, int gw, int NGW) {
    unsigned char* ws = a->ws;
    LAS float* scr = (LAS float*)(lds + wave * 16640);
    constexpr int I_W1 = (D / 64) * (FF / 64), I_W2 = (FF / 64) * (D / 64), I_C6 = (D / 64) * (NQKV / 64), I_DD = (D / 64) * (D / 64), I_PG = (512 / 64) * (512 / 64), I_GLU = (D / 64) * (4096 / 64);
    constexpr int NITEMS = 4 * I_W1 + 4 * I_W2 + 2 * I_C6 + 3 * I_DD + 4 * I_PG + I_GLU;
    for (int it = gw; it < NITEMS; it += NGW) {
        int r = it;
        if (r < 4 * I_W1) { const int l = r / I_W1; transpose_item(a->in[3] + (size_t)l * D * FF, D, FF, (bf16*)(ws + WS_W1T) + (size_t)l * D * FF, 0, a->in[2] + (size_t)l * D, scr, r % I_W1, lane); continue; } r -= 4 * I_W1;
        if (r < 4 * I_W2) { const int l = r / I_W2; transpose_item(a->in[4] + (size_t)l * D * FF, FF, D, (bf16*)(ws + WS_W2T) + (size_t)l * D * FF, 0, nullptr, scr, r % I_W2, lane); continue; } r -= 4 * I_W2;
        if (r < I_C6) { transpose_item(a->in[5], D, NQKV, (bf16*)(ws + WS_CINT), 0, a->in[1], scr, r, lane); continue; } r -= I_C6;
        if (r < I_C6) { transpose_item(a->in[11], D, NQKV, (bf16*)(ws + WS_QKVT), 0, a->in[1] + 2 * D, scr, r, lane); continue; } r -= I_C6;
        if (r < I_DD) { transpose_item(a->in[7], D, D, (bf16*)(ws + WS_COUTT), 0, nullptr, scr, r, lane); continue; } r -= I_DD;
        if (r < I_DD) { transpose_item(a->in[8], D, D, (bf16*)(ws + WS_PINT), 0, a->in[1] + D, scr, r, lane); continue; } r -= I_DD;
        if (r < I_DD) { transpose_item(a->in[15], D, D, (bf16*)(ws + WS_AOUTT), 0, nullptr, scr, r, lane); continue; } r -= I_DD;
        if (r < 4 * I_PG) { const int g = r / I_PG; transpose_item(a->in[9] + (size_t)g * 512 * 512, 512, 512, (bf16*)(ws + WS_PGT) + (size_t)g * 512 * 512, 0, nullptr, scr, r % I_PG, lane); continue; } r -= 4 * I_PG;
        transpose_item(a->in[24], D, 4096, (bf16*)(ws + WS_GLUT), 1, nullptr, scr, r, lane);
    }
    for (int i = gw * 64 + lane; i < 128 * 64; i += NGW * 64) {
        f32x2 ab, cf; ssm_coef(a->in[16], a->in[17], a->in[18], i >> 6, i & 63, ab, cf);
        ((f32x2*)(ws + WS_ABAR))[i] = ab;
        f32x2* bb = (f32x2*)(ws + WS_BBAR) + (size_t)i * 16;
        const float* br = a->in[19] + (size_t)i * 16; const float* bi = a->in[20] + (size_t)i * 16;
#pragma unroll
        for (int c = 0; c < 16; ++c) bb[c] = (f32x2){cf.x * br[c] - cf.y * bi[c], cf.x * bi[c] + cf.y * br[c]};
    }
    ssm_ktab(a->in[16], a->in[17], a->in[18], a->in[19], a->in[20], a->in[21], a->in[22], (bf16*)(ws + WS_KT), scr, lane, gw, NGW);
    { unsigned* sq = (unsigned*)(ws + WS_SSQ); for (int i = gw * 64 + lane; i < 7 * S; i += NGW * 64) sq[S + i] = 0u;
      xb_rows(a->in[0], (bf16*)(ws + WS_H), sq, gw, NGW, lane); }
}

DI void unpack8(const u32x4 w, float (&f)[8]) { f[0] = bf_lo(w.x); f[1] = bf_hi(w.x); f[2] = bf_lo(w.y); f[3] = bf_hi(w.y); f[4] = bf_lo(w.z); f[5] = bf_hi(w.z); f[6] = bf_lo(w.w); f[7] = bf_hi(w.w); }
DI u32x4 pack8(const float (&f)[8]) { u32x4 o; o.x = cvt_pk_bf16(f[0], f[1]); o.y = cvt_pk_bf16(f[2], f[3]); o.z = cvt_pk_bf16(f[4], f[5]); o.w = cvt_pk_bf16(f[6], f[7]); return o; }
DI f32x2 cmul(f32x2 a, f32x2 b) { return (f32x2){a.x * b.x - a.y * b.y, a.x * b.y + a.y * b.x}; }
DI bf16x8 pack8v(const float (&f)[8]) { const u32x4 o = pack8(f); return __builtin_bit_cast(bf16x8, o); }

DI void conv_gate_phase(const bf16* BCV, const float* cw, bf16* G, int gtid, int nthr) {
    for (int idx = gtid; idx < 256 * 512; idx += nthr) {
        const int c0 = (idx & 255) * 8, t0 = (idx >> 8) * 16;
        float w0[8], w1[8], w2[8], um1[8], um2[8];
#pragma unroll
        for (int e = 0; e < 8; ++e) { w0[e] = cw[c0 + e]; w1[e] = cw[D + c0 + e]; w2[e] = cw[2 * D + c0 + e]; um1[e] = 0.f; um2[e] = 0.f; }
        if (t0 >= 2) {
            float cgv[8], vv[8];
            const bf16* r2 = BCV + (size_t)(t0 - 2) * NQKV + c0; unpack8(*(const u32x4*)(r2 + D), cgv); unpack8(*(const u32x4*)(r2 + 2 * D), vv);
#pragma unroll
            for (int e = 0; e < 8; ++e) um2[e] = cgv[e] * vv[e];
            const bf16* r1 = BCV + (size_t)(t0 - 1) * NQKV + c0; unpack8(*(const u32x4*)(r1 + D), cgv); unpack8(*(const u32x4*)(r1 + 2 * D), vv);
#pragma unroll
            for (int e = 0; e < 8; ++e) um1[e] = cgv[e] * vv[e];
        }
        for (int t = t0; t < t0 + 16; ++t) {
            const bf16* r = BCV + (size_t)t * NQKV + c0;
            float bv[8], cgv[8], vv[8], o[8];
            unpack8(*(const u32x4*)(r), bv); unpack8(*(const u32x4*)(r + D), cgv); unpack8(*(const u32x4*)(r + 2 * D), vv);
#pragma unroll
            for (int e = 0; e < 8; ++e) { const float u = cgv[e] * vv[e]; o[e] = bv[e] * (w0[e] * um2[e] + w1[e] * um1[e] + w2[e] * u); um2[e] = um1[e]; um1[e] = u; }
            *(u32x4*)(G + (size_t)t * D + c0) = pack8(o);
        }
    }
}

DI void pool_phase(const bf16* U, bf16* G, int gtid, int nthr) {
    for (int idx = gtid; idx < 256 * 512; idx += nthr) {
        const int c0 = (idx & 255) * 8, t0 = (idx >> 8) * 16, w = 2 << (c0 >> 9);
        float sum[8];
#pragma unroll
        for (int e = 0; e < 8; ++e) sum[e] = 0.f;
        for (int j = 1; j < w; ++j) { const int t = t0 - j; if (t >= 0) { float f[8]; unpack8(*(const u32x4*)(U + (size_t)t * D + c0), f);
#pragma unroll
                for (int e = 0; e < 8; ++e) sum[e] += f[e]; } }
        for (int t = t0; t < t0 + 16; ++t) {
            float f[8], o[8]; unpack8(*(const u32x4*)(U + (size_t)t * D + c0), f);
            const float inv = 1.f / (float)((t + 1) < w ? (t + 1) : w);
#pragma unroll
            for (int e = 0; e < 8; ++e) { sum[e] += f[e]; o[e] = sum[e] * inv - f[e]; }
            *(u32x4*)(G + (size_t)t * D + c0) = pack8(o);
            const int tr = t - w + 1;
            if (tr >= 0) { float r[8]; unpack8(*(const u32x4*)(U + (size_t)tr * D + c0), r);
#pragma unroll
                for (int e = 0; e < 8; ++e) sum[e] -= r[e]; }
        }
    }
}

DI void qknorm_phase(bf16* QKV, const float* qg, const float* kg, bf16* VT, LAS unsigned char* lds, int wave, int lane, int gw, int NGW) {
    LAS unsigned char* tl = lds + wave * 17408;
    for (int tile = gw; tile < 128 * 16; tile += NGW) {
        const int h = tile & 15, c = tile >> 4, t0 = c * 64;
#pragma unroll
        for (int i = 0; i < 16; ++i) { const int pc = i * 64 + lane, t = pc >> 4, q = pc & 15;
            const u32x4 v = *(const u32x4*)(QKV + (size_t)(t0 + t) * NQKV + 2 * D + h * 128 + q * 8);
            *(LAS u32x4*)(tl + t * 272 + q * 16) = v; }
        LDS_WAIT(); asm volatile("" ::: "memory");
#pragma unroll
        for (int it = 0; it < 16; ++it) { const int d = lane + 64 * (it & 1), pp = it >> 1;
            unsigned short e[8];
#pragma unroll
            for (int k = 0; k < 8; ++k) e[k] = *(const LAS unsigned short*)(tl + (8 * pp + k) * 272 + d * 2);
            u32x4 o; o.x = e[0] | ((unsigned)e[1] << 16); o.y = e[2] | ((unsigned)e[3] << 16); o.z = e[4] | ((unsigned)e[5] << 16); o.w = e[6] | ((unsigned)e[7] << 16);
            *(u32x4*)(VT + (size_t)(h * 128 + d) * S + t0 + 8 * pp) = o; }
        LDS_WAIT(); asm volatile("" ::: "memory");
    }
}

DI void attn_phase(const bf16* QKV, const bf16* VT, const float* rel_bias, const float* qgain, const float* kgain, bf16* O, LAS unsigned char* lds, int tid, int wave, int lane) {
    constexpr int KROW = 272, VROW = 144, VOFF = 64 * KROW, BUF = VOFF + 128 * VROW;
    LAS float* btab = (LAS float*)(lds + 2 * BUF);
    const int fr = lane & 15, fq = lane >> 4;
    for (int wu = blockIdx.x; wu < 512; wu += gridDim.x) {
        const int h = wu & 15, c0 = (wu >> 4) * 4, c = c0 + (wave >> 1), qh = wave & 1;
        __syncthreads();
        for (int i = tid; i < 513; i += 512) btab[i] = rel_bias[h * 513 + i] * LOG2E;
        const int tq0 = 64 * c + 32 * qh;
        bf16x8 Qf[2][4];
#pragma unroll
        for (int qt = 0; qt < 2; ++qt)
#pragma unroll
            for (int ks = 0; ks < 4; ++ks) Qf[qt][ks] = *(const bf16x8*)(QKV + (size_t)(tq0 + 16 * qt + fr) * NQKV + h * 128 + 32 * ks + 8 * fq);
#pragma unroll
        for (int qt = 0; qt < 2; ++qt) { float qf[4][8]; float ss = 0.f;
#pragma unroll
            for (int ks = 0; ks < 4; ++ks) { unpack8(__builtin_bit_cast(u32x4, Qf[qt][ks]), qf[ks]);
#pragma unroll
                for (int e = 0; e < 8; ++e) ss += qf[ks][e] * qf[ks][e]; }
            ss += __shfl_xor(ss, 16); ss += __shfl_xor(ss, 32);
            const float rq = ATT_QSCALE / sqrtf(ss * (1.f / 128.f) + RMS_EPS);
#pragma unroll
            for (int ks = 0; ks < 4; ++ks) { const f32x4 g0 = *(const f32x4*)(qgain + 32 * ks + 8 * fq), g1 = *(const f32x4*)(qgain + 32 * ks + 8 * fq + 4);
                const float gg[8] = {g0.x, g0.y, g0.z, g0.w, g1.x, g1.y, g1.z, g1.w};
#pragma unroll
                for (int e = 0; e < 8; ++e) qf[ks][e] = qf[ks][e] * rq * gg[e];
                Qf[qt][ks] = pack8v(qf[ks]); } }
        f32x4 Oa[2][8];
#pragma unroll
        for (int qt = 0; qt < 2; ++qt)
#pragma unroll
            for (int dt = 0; dt < 8; ++dt) Oa[qt][dt] = (f32x4){0.f, 0.f, 0.f, 0.f};
        float mrun[2] = {-1e30f, -1e30f}, lrun[2] = {0.f, 0.f};
        const int kc_lo = (c0 - 8) > 0 ? (c0 - 8) : 0, kc_hi = c0 + 3;
        const bf16* kg = QKV + (size_t)(tid >> 4) * NQKV + D + h * 128 + (tid & 15) * 8;
        const bf16* vg = VT + (size_t)(h * 128 + (tid >> 3)) * S + (tid & 7) * 8;
        const int klds = (tid >> 4) * KROW + (tid & 15) * 16, vlds = VOFF + (tid >> 3) * VROW + (tid & 7) * 16;
        u32x4 kreg[2], vreg[2];
#define ATT_KNORM() do { const f32x4 g0 = *(const f32x4*)(kgain + (tid & 15) * 8), g1 = *(const f32x4*)(kgain + (tid & 15) * 8 + 4); const float gkk[8] = {g0.x, g0.y, g0.z, g0.w, g1.x, g1.y, g1.z, g1.w}; \
            _Pragma("unroll") for (int e = 0; e < 2; ++e) { float kf[8]; unpack8(kreg[e], kf); float ss = 0.f; \
            _Pragma("unroll") for (int k = 0; k < 8; ++k) ss += kf[k] * kf[k]; \
            ss += __shfl_xor(ss, 1); ss += __shfl_xor(ss, 2); ss += __shfl_xor(ss, 4); ss += __shfl_xor(ss, 8); \
            const float rk = 1.f / sqrtf(ss * (1.f / 128.f) + RMS_EPS); \
            _Pragma("unroll") for (int k = 0; k < 8; ++k) kf[k] = kf[k] * rk * gkk[k]; \
            kreg[e] = pack8(kf); } } while (0)
#pragma unroll
        for (int e = 0; e < 2; ++e) { kreg[e] = *(const u32x4*)(kg + (size_t)(64 * kc_lo + 32 * e) * NQKV); vreg[e] = *(const u32x4*)(vg + (size_t)(64 * e) * S + 64 * kc_lo); }
        ATT_KNORM();
#pragma unroll
        for (int e = 0; e < 2; ++e) { *(LAS u32x4*)(lds + klds + 32 * e * KROW) = kreg[e]; *(LAS u32x4*)(lds + vlds + 64 * e * VROW) = vreg[e]; }
        for (int kc = kc_lo; kc <= kc_hi; ++kc) {
            const int bo = ((kc - kc_lo) & 1) * BUF;
            if (kc < kc_hi) {
#pragma unroll
                for (int e = 0; e < 2; ++e) { kreg[e] = *(const u32x4*)(kg + (size_t)(64 * (kc + 1) + 32 * e) * NQKV); vreg[e] = *(const u32x4*)(vg + (size_t)(64 * e) * S + 64 * (kc + 1)); }
            }
            LDS_WAIT(); __syncthreads();
            if (kc >= c - 8 && kc <= c) {
#pragma unroll
                for (int bb = 0; bb < 2; ++bb) {
                    const int tk0 = 64 * kc + 32 * bb;
                    f32x4 sc[2][2];
#pragma unroll
                    for (int kt = 0; kt < 2; ++kt) { bf16x8 Kf[4];
#pragma unroll
                        for (int ks = 0; ks < 4; ++ks) Kf[ks] = *(const LAS bf16x8*)(lds + bo + (32 * bb + 8 * (fr >> 2) + 4 * kt + (fr & 3)) * KROW + (32 * ks + 8 * fq) * 2);
#pragma unroll
                        for (int qt = 0; qt < 2; ++qt) { f32x4 a = (f32x4){0.f, 0.f, 0.f, 0.f};
#pragma unroll
                            for (int ks = 0; ks < 4; ++ks) a = __builtin_amdgcn_mfma_f32_16x16x32_bf16(Kf[ks], Qf[qt][ks], a, 0, 0, 0);
                            sc[kt][qt] = a; } }
                    asm volatile("s_nop 7\n\ts_nop 7\n\ts_nop 7" : "+v"(sc[0][0]), "+v"(sc[0][1]), "+v"(sc[1][0]), "+v"(sc[1][1]));
                    asm volatile("s_nop 7" : "+v"(Oa[0][0]), "+v"(Oa[0][1]), "+v"(Oa[0][2]), "+v"(Oa[0][3]), "+v"(Oa[0][4]), "+v"(Oa[0][5]), "+v"(Oa[0][6]), "+v"(Oa[0][7]));
                    asm volatile("s_nop 7" : "+v"(Oa[1][0]), "+v"(Oa[1][1]), "+v"(Oa[1][2]), "+v"(Oa[1][3]), "+v"(Oa[1][4]), "+v"(Oa[1][5]), "+v"(Oa[1][6]), "+v"(Oa[1][7]));
                    bf16x8 Pf[2];
#pragma unroll
                    for (int qt = 0; qt < 2; ++qt) {
                        const int dbase = (tq0 + 16 * qt + fr) - (tk0 + 8 * fq);
                        float sv[8]; float mx = -1e30f;
#pragma unroll
                        for (int kt = 0; kt < 2; ++kt)
#pragma unroll
                            for (int r = 0; r < 4; ++r) { int dl = dbase - 4 * kt - r; dl = dl > 256 ? 256 : dl; const float v = sc[kt][qt][r] + btab[dl + 256]; sv[4 * kt + r] = v; mx = fmaxf(mx, v); }
                        mx = fmaxf(mx, __shfl_xor(mx, 16)); mx = fmaxf(mx, __shfl_xor(mx, 32));
                        const float mnew = fmaxf(mrun[qt], mx), alpha = __builtin_amdgcn_exp2f(mrun[qt] - mnew);
                        mrun[qt] = mnew;
                        float ps = 0.f;
#pragma unroll
                        for (int e = 0; e < 8; ++e) { sv[e] = __builtin_amdgcn_exp2f(sv[e] - mnew); ps += sv[e]; }
                        lrun[qt] = lrun[qt] * alpha + ps;
                        u32x4 pk; pk.x = cvt_pk_bf16(sv[0], sv[1]); pk.y = cvt_pk_bf16(sv[2], sv[3]); pk.z = cvt_pk_bf16(sv[4], sv[5]); pk.w = cvt_pk_bf16(sv[6], sv[7]);
                        Pf[qt] = __builtin_bit_cast(bf16x8, pk);
#pragma unroll
                        for (int dt = 0; dt < 8; ++dt) Oa[qt][dt] = Oa[qt][dt] * alpha;
                    }
                    asm volatile("s_nop 3" : "+v"(Pf[0]), "+v"(Pf[1]));
#pragma unroll
                    for (int dt = 0; dt < 8; ++dt) { const bf16x8 Vf = *(const LAS bf16x8*)(lds + bo + VOFF + (16 * dt + fr) * VROW + (32 * bb + 8 * fq) * 2);
#pragma unroll
                        for (int qt = 0; qt < 2; ++qt) Oa[qt][dt] = __builtin_amdgcn_mfma_f32_16x16x32_bf16(Vf, Pf[qt], Oa[qt][dt], 0, 0, 0); }
                }
            }
            if (kc < kc_hi) {
                ATT_KNORM();
#pragma unroll
                for (int e = 0; e < 2; ++e) { *(LAS u32x4*)(lds + (BUF - bo) + klds + 32 * e * KROW) = kreg[e]; *(LAS u32x4*)(lds + (BUF - bo) + vlds + 64 * e * VROW) = vreg[e]; }
            }
        }
#pragma unroll
        for (int qt = 0; qt < 2; ++qt) {
            float l = lrun[qt]; l += __shfl_xor(l, 16); l += __shfl_xor(l, 32);
            const float inv = 1.f / l;
            bf16* op = O + (size_t)(tq0 + 16 * qt + fr) * D + h * 128 + 4 * fq;
#pragma unroll
            for (int dt = 0; dt < 8; ++dt) { const f32x4 o = Oa[qt][dt] * inv; u32x2 w; w.x = cvt_pk_bf16(o.x, o.y); w.y = cvt_pk_bf16(o.z, o.w); *(u32x2*)(op + 16 * dt) = w; }
        }
    }
}

DI float gelu_tanh(float y) { const float t = 0.7978845608028654f * (y + 0.044715f * y * y * y); const float e = __expf(2.f * t); const float th = 1.f - 2.f * __builtin_amdgcn_rcpf(e + 1.f); return 0.5f * y * (1.f + th); }

DI void ssm_coef(const float* a_re, const float* a_im, const float* log_dt, int g, int n, f32x2& abar, f32x2& coef) {
    const float dt = expf(log_dt[g]), lr = a_re[g * 64 + n], li = a_im[g * 64 + n];
    const float xr = lr * dt, yi = li * dt, ex = expf(xr), em1 = expm1f(xr);
    const float cy = cosf(yi), sy = sinf(yi), sh = sinf(0.5f * yi);
    const float ar = ex * cy, ai = ex * sy;
    const float pr = em1 * cy - 2.f * sh * sh, pi = ai;
    const float den = 1.f / (lr * lr + li * li);
    abar = (f32x2){ar, ai}; coef = (f32x2){(pr * lr + pi * li) * den, (pi * lr - pr * li) * den};
}
DI void ssm_ktab(const float* a_re, const float* a_im, const float* log_dt, const float* b_re, const float* b_im, const float* c_re, const float* c_im, bf16* Kt, LAS float* scr, int lane, int gw, int NGW) {
    const int fr = lane & 15, fq = lane >> 4;
    for (int u = gw; u < 128 * 16; u += NGW) {
        const int g = u >> 4, seg = u & 15;
#pragma unroll 1
        for (int idx = 0; idx < 16; ++idx) { const int n = 32 * (idx >> 3) + 8 * fq + (idx & 7);
            f32x2 av, cf; ssm_coef(a_re, a_im, log_dt, g, n, av, cf);
            const float rb = b_re[(size_t)(g * 64 + n) * 16 + fr], ib = b_im[(size_t)(g * 64 + n) * 16 + fr];
            *(LAS f32x4*)(scr + (idx * 64 + lane) * 4) = (f32x4){av.x, av.y, cf.x * rb - cf.y * ib, cf.x * ib + cf.y * rb}; }
        LDS_WAIT(); asm volatile("" ::: "memory");
        f32x2 a[16], p[16]; float br[16], bi[16];
#pragma unroll
        for (int idx = 0; idx < 16; ++idx) { const f32x4 t = *(const LAS f32x4*)(scr + (idx * 64 + lane) * 4);
            a[idx] = (f32x2){t.x, t.y}; br[idx] = t.z; bi[idx] = t.w;
            f32x2 pw = cmul(a[idx], a[idx]); pw = cmul(pw, pw);
            float one = 1.f; asm volatile("" : "+v"(one));
            f32x2 pp = (f32x2){one, 0.f};
#pragma unroll
            for (int bit = 0; bit < 4; ++bit) { if ((seg >> bit) & 1) pp = cmul(pp, pw); pw = cmul(pw, pw); }
            p[idx] = pp; }
        LDS_WAIT(); asm volatile("" ::: "memory");
        bf16x8 Cm[4];
#pragma unroll
        for (int ks = 0; ks < 4; ++ks) { const float* src = (ks < 2 ? c_re : c_im) + (size_t)(g * 16 + fr) * 64 + (ks & 1) * 32 + 8 * fq;
            const f32x4 x0 = *(const f32x4*)src, x1 = *(const f32x4*)(src + 4); const float sg = ks < 2 ? 1.f : -1.f;
            const float f[8] = {sg * x0.x, sg * x0.y, sg * x0.z, sg * x0.w, sg * x1.x, sg * x1.y, sg * x1.z, sg * x1.w};
            Cm[ks] = pack8v(f); }
        for (int tt = 0; tt < 4; ++tt) {
            const int tau = 4 * seg + tt;
            f32x4 acc = (f32x4){0.f, 0.f, 0.f, 0.f};
#pragma unroll
            for (int h = 0; h < 2; ++h) { float qr[8], qi[8];
#pragma unroll
                for (int e = 0; e < 8; ++e) { const int idx = 8 * h + e; qr[e] = p[idx].x * br[idx] - p[idx].y * bi[idx]; qi[e] = p[idx].y * br[idx] + p[idx].x * bi[idx]; }
                const bf16x8 fqr = pack8v(qr), fqi = pack8v(qi); MFMA_SETTLE();
                acc = __builtin_amdgcn_mfma_f32_16x16x32_bf16(Cm[h], fqr, acc, 0, 0, 0);
                acc = __builtin_amdgcn_mfma_f32_16x16x32_bf16(Cm[2 + h], fqi, acc, 0, 0, 0); }
            MFMA_SETTLE();
            bf16* kp = Kt + ((size_t)(g * 64 + tau) * 16 + 4 * fq) * 16 + fr;
#pragma unroll
            for (int r = 0; r < 4; ++r) kp[r * 16] = (bf16)(cvt_pk_bf16(acc[r], 0.f) & 0xffffu);
#pragma unroll
            for (int idx = 0; idx < 16; ++idx) p[idx] = cmul(p[idx], a[idx]);
        }
    }
}

DI void ssm_passA(const bf16* H, const unsigned* ssq, const float* gain, const f32x2* abar, const f32x2* bbar, f32x2* F, int lane, int gw, int NGW) {
    const int fr = lane & 15, fq = lane >> 4;
    bf16x8 Bb[8]; f32x2 a1[4], a16[4], lp[4]; float gq[8];
    int gprev = -1;
    for (int u = gw; u < 128 * 128; u += NGW) {
        const int g = u & 127, j = u >> 7;
        u32x4 uv[4]; float rsd[4];
#pragma unroll
        for (int i = 0; i < 4; ++i) { uv[i] = (u32x4){0u, 0u, 0u, 0u}; if (fq < 2) uv[i] = *(const u32x4*)(H + (size_t)(j * 64 + 16 * i + fr) * D + g * 16 + 8 * fq); rsd[i] = (float)ssq[j * 64 + 16 * i + fr] * (1.f / 1024.f); }
        if (g != gprev) {
            gprev = g;
#pragma unroll
            for (int e = 0; e < 8; ++e) gq[e] = gain[g * 16 + 8 * (fq & 1) + e];
#pragma unroll
            for (int q = 0; q < 4; ++q) { const int n = 16 * q + fr;
                float re[8], im[8];
#pragma unroll
                for (int e = 0; e < 8; ++e) { re[e] = 0.f; im[e] = 0.f; }
                if (fq < 2) { const f32x4* bp = (const f32x4*)(bbar + (size_t)(g * 64 + n) * 16 + 8 * fq);
#pragma unroll
                    for (int e = 0; e < 4; ++e) { const f32x4 t = bp[e]; re[2 * e] = t.x; im[2 * e] = t.y; re[2 * e + 1] = t.z; im[2 * e + 1] = t.w; } }
                Bb[q] = pack8v(re); Bb[q + 4] = pack8v(im);
                const f32x2 a = abar[g * 64 + n], a2 = cmul(a, a), a4 = cmul(a2, a2), a8 = cmul(a4, a4);
                a1[q] = a; a16[q] = cmul(a8, a8);
                float one = 1.f; asm volatile("" : "+v"(one));
                lp[q] = fq == 3 ? (f32x2){one, 0.f} : (fq == 2 ? a4 : (fq == 1 ? a8 : cmul(a8, a4))); }
        }
        f32x2 acc[4];
#pragma unroll
        for (int q = 0; q < 4; ++q) acc[q] = (f32x2){0.f, 0.f};
#pragma unroll
        for (int i = 0; i < 4; ++i) {
            float uf[8]; unpack8(uv[i], uf); const float rst = 1.f / sqrtf(rsd[i] * (1.f / D) + RMS_EPS);
#pragma unroll
            for (int e = 0; e < 8; ++e) uf[e] = uf[e] * rst * gq[e];
            const bf16x8 Ua = pack8v(uf);
            MFMA_SETTLE();
#pragma unroll
            for (int q = 0; q < 4; ++q) {
                const f32x4 z = (f32x4){0.f, 0.f, 0.f, 0.f};
                const f32x4 dr = __builtin_amdgcn_mfma_f32_16x16x32_bf16(Ua, Bb[q], z, 0, 0, 0), di = __builtin_amdgcn_mfma_f32_16x16x32_bf16(Ua, Bb[q + 4], z, 0, 0, 0);
                MFMA_SETTLE();
                f32x2 h = (f32x2){dr[0], di[0]};
#pragma unroll
                for (int r = 1; r < 4; ++r) { h = cmul(h, a1[q]); h.x += dr[r]; h.y += di[r]; }
                const f32x2 t = cmul(acc[q], a16[q]); acc[q] = (f32x2){t.x + h.x, t.y + h.y}; }
        }
#pragma unroll
        for (int q = 0; q < 4; ++q) { f32x2 f = cmul(acc[q], lp[q]);
            f.x += __shfl_xor(f.x, 16); f.x += __shfl_xor(f.x, 32); f.y += __shfl_xor(f.y, 16); f.y += __shfl_xor(f.y, 32);
            if (fq == 0) F[(size_t)j * 8192 + g * 64 + 16 * q + fr] = f; }
    }
}

DI void ssm_passB(const bf16* H, const unsigned* ssq, const float* gain, const f32x2* abar, const float* c_re, const float* c_im, const float* dsk, const f32x2* F, const bf16* Kt, bf16* Z, LAS unsigned char* lds, int tid, int wave, int lane) {
    const int fr = lane & 15, fq = lane >> 4, n = lane;
    LAS unsigned char* Kl = lds;
    LAS unsigned char* St = lds + 32768 + wave * 11264;
    LAS unsigned char* Uc = St + 8704;
    int gprev = -1, jdone = 0;
    f32x2 a = (f32x2){0.f, 0.f}, aL = a, carry = a; bf16x8 Cm[4]; f32x4 dd = (f32x4){0.f, 0.f, 0.f, 0.f}; float gq[8];
    for (int wu = blockIdx.x; wu < 2048; wu += gridDim.x) {
        const int g = wu & 127, j = (wu >> 7) * 8 + wave;
        if (g != gprev) {
            __syncthreads();
#pragma unroll
            for (int i = 0; i < 4; ++i) { const int idx = i * 512 + tid; *(LAS u32x4*)(Kl + idx * 16) = *(const u32x4*)(Kt + (size_t)g * 16384 + idx * 8); }
            a = abar[g * 64 + n]; aL = a;
#pragma unroll
            for (int q = 0; q < 6; ++q) aL = cmul(aL, aL);
#pragma unroll
            for (int ks = 0; ks < 4; ++ks) { const size_t o = (size_t)(g * 16 + fr) * 64 + 16 * ks + 4 * fq;
                const f32x4 cr = *(const f32x4*)(c_re + o), ci = *(const f32x4*)(c_im + o);
                const float f[8] = {cr.x, -ci.x, cr.y, -ci.y, cr.z, -ci.z, cr.w, -ci.w};
                Cm[ks] = pack8v(f); }
            dd = *(const f32x4*)(dsk + g * 16 + 4 * fq);
#pragma unroll
            for (int e = 0; e < 8; ++e) gq[e] = gain[g * 16 + 8 * (lane & 1) + e];
            carry = (f32x2){0.f, 0.f}; jdone = 0;
            LDS_WAIT(); __syncthreads();
            gprev = g;
        }
        if (j < jdone) { carry = (f32x2){0.f, 0.f}; jdone = 0; }
        { const f32x2* Fp = F + (size_t)g * 64 + n;
#pragma unroll 16
          for (int i = jdone; i < j; ++i) { const f32x2 f = Fp[(size_t)i * 8192]; const f32x2 t = cmul(carry, aL); carry = (f32x2){t.x + f.x, t.y + f.y}; }
          jdone = j; }
        f32x2 p = carry;
        { unsigned zr = 0u; asm volatile("" : "+v"(zr));
          if (lane < 32) *(LAS u32x4*)(Uc + lane * 16) = (u32x4){zr, zr, zr, zr}; }
#pragma unroll
        for (int e = 0; e < 2; ++e) { const int pc = lane + 64 * e, tok = pc >> 1, hf = pc & 1;
            float uf[8]; unpack8(*(const u32x4*)(H + (size_t)(j * 64 + tok) * D + g * 16 + 8 * hf), uf); const float rst = 1.f / sqrtf((float)ssq[j * 64 + tok] * (1.f / (1024.f * D)) + RMS_EPS);
#pragma unroll
            for (int k = 0; k < 8; ++k) uf[k] = uf[k] * rst * gq[k];
            *(LAS u32x4*)(Uc + (tok + 16) * 32 + hf * 16) = pack8(uf); }
        f32x4 acc[4];
#pragma unroll
        for (int hb = 0; hb < 2; ++hb) {
            for (int tt = 0; tt < 32; ++tt) { p = cmul(p, a); *(LAS unsigned*)(St + tt * 272 + n * 4) = cvt_pk_bf16(p.x, p.y); }
            LDS_WAIT(); asm volatile("" ::: "memory"); __builtin_amdgcn_wave_barrier();
#pragma unroll
            for (int ii = 0; ii < 2; ++ii) { f32x4 c4 = (f32x4){0.f, 0.f, 0.f, 0.f};
#pragma unroll
                for (int ks = 0; ks < 4; ++ks) { const bf16x8 Pf = *(const LAS bf16x8*)(St + (16 * ii + fr) * 272 + (32 * ks + 8 * fq) * 2); c4 = __builtin_amdgcn_mfma_f32_16x16x32_bf16(Cm[ks], Pf, c4, 0, 0, 0); }
                MFMA_SETTLE(); acc[2 * hb + ii] = c4; }
            LDS_WAIT(); asm volatile("" ::: "memory"); __builtin_amdgcn_wave_barrier();
        }
#pragma unroll
        for (int s = 0; s < 32; ++s) {
            const bf16x8 Af = *(const LAS bf16x8*)(Kl + (2 * s + (fq >> 1)) * 512 + fr * 32 + (fq & 1) * 16);
#pragma unroll
            for (int i = 0; i < 4; ++i) if (i >= (s >> 3)) {
                const int row = 16 * i + fr - (2 * s + (fq >> 1));
                const bf16x8 Bf = *(const LAS bf16x8*)(Uc + (row + 16) * 32 + (fq & 1) * 16);
                acc[i] = __builtin_amdgcn_mfma_f32_16x16x32_bf16(Af, Bf, acc[i], 0, 0, 0); }
        }
        MFMA_SETTLE();
#pragma unroll
        for (int i = 0; i < 4; ++i) {
            const u32x2 hv = *(const LAS u32x2*)(Uc + (16 * i + fr + 16) * 32 + fq * 8);
            const f32x4 uv = (f32x4){bf_lo(hv.x), bf_hi(hv.x), bf_lo(hv.y), bf_hi(hv.y)};
            const f32x4 y = acc[i] + dd * uv;
            u32x2 w; w.x = cvt_pk_bf16(gelu_tanh(y.x), gelu_tanh(y.y)); w.y = cvt_pk_bf16(gelu_tanh(y.z), gelu_tanh(y.w));
            *(u32x2*)(Z + (size_t)(j * 64 + 16 * i + fr) * D + g * 16 + 4 * fq) = w; }
        LDS_WAIT(); asm volatile("" ::: "memory"); __builtin_amdgcn_wave_barrier();
    }
}

#define XB_TMO      128
#define XB_XCNT(j)  (256  + 64 * (j))
#define XB_XSUB(j)  (1280 + 64 * (j))
#define XB_XGEN(j)  (2304 + 64 * (j))
#define XB_TOP      3328
#define XB_TOPGEN   3392
#define XCD_BAR_WORDS 3456
#define XB_SPIN_CAP (1u << 18)

__device__ __forceinline__ unsigned xb_ld(unsigned* p)              { return __hip_atomic_load(p, __ATOMIC_RELAXED, __HIP_MEMORY_SCOPE_AGENT); }
__device__ __forceinline__ unsigned xb_add(unsigned* p, unsigned v) { return __hip_atomic_fetch_add(p, v, __ATOMIC_RELAXED, __HIP_MEMORY_SCOPE_AGENT); }
__device__ __forceinline__ unsigned xb_xcc_id() { return (unsigned)__builtin_amdgcn_s_getreg((3 << 11) | 20) & 0xFu; }
#define XB_SPIN(cond, bar) do { unsigned _sp = 0; while (cond) { __builtin_amdgcn_s_sleep(1); \
    if ((++_sp & 255u) == 0u) { if (xb_ld(&(bar)[XB_TMO])) break; if (_sp > XB_SPIN_CAP) { atomicAdd(&(bar)[XB_TMO], 1u); break; } } } } while (0)

struct XcdBarrier {
    unsigned* bar; unsigned x;
    volatile LAS unsigned* st;
};

__device__ __forceinline__ XcdBarrier xcd_barrier_post(unsigned* bar, volatile LAS unsigned* st) {
    XcdBarrier b; b.bar = bar; b.x = xb_xcc_id(); b.st = st;
    if (threadIdx.x == 0) (void)xb_add(&bar[XB_XCNT(b.x)], 1u);
    return b;
}
__device__ __forceinline__ void xcd_barrier_complete(unsigned* bar, unsigned x, unsigned& nloc, unsigned& nx) {
    const unsigned G = gridDim.x * gridDim.y * gridDim.z;
    unsigned sum, cnt, mine, sp = 0u;
    for (;;) {
        sum = 0u; cnt = 0u; mine = 0u;
#pragma unroll
        for (unsigned j = 0; j < 16; ++j) { const unsigned c = xb_ld(&bar[XB_XCNT(j)]); sum += c; cnt += (c > 0u) ? 1u : 0u; mine = (j == x) ? c : mine; }
        if (sum == G) break;
        __builtin_amdgcn_s_sleep(1);
        if ((++sp & 255u) == 0u) { if (xb_ld(&bar[XB_TMO])) break; if (sp > XB_SPIN_CAP) { atomicAdd(&bar[XB_TMO], 1u); break; } }
    }
    nloc = mine > 0u ? mine : 1u; nx = cnt > 0u ? cnt : 1u;
}

__device__ __forceinline__ void xcd_barrier(const XcdBarrier& b) {
    asm volatile("s_waitcnt vmcnt(0)" ::: "memory");
    __syncthreads();
    if (threadIdx.x == 0) {
        unsigned* bar = b.bar;
        __builtin_amdgcn_s_waitcnt(0);
        unsigned nloc = b.st[0], nx = b.st[1];
        if (nloc == 0u) { xcd_barrier_complete(bar, b.x, nloc, nx); b.st[0] = nloc; b.st[1] = nx; }
        const unsigned old = xb_add(&bar[XB_XSUB(b.x)], 1u);
        const unsigned gen = old / nloc;
        if (old + 1u == (gen + 1u) * nloc) {
            __builtin_amdgcn_fence(__ATOMIC_RELEASE, "agent");
            asm volatile("s_waitcnt vmcnt(0)" ::: "memory");
            const unsigned og = xb_add(&bar[XB_TOP], 1u);
            const unsigned tg = og / nx;
            if (og + 1u == (tg + 1u) * nx) xb_add(&bar[XB_TOPGEN], 1u);
            else XB_SPIN(xb_ld(&bar[XB_TOPGEN]) == tg, bar);
            __builtin_amdgcn_fence(__ATOMIC_ACQUIRE, "agent");
            xb_add(&bar[XB_XGEN(b.x)], 1u);
            asm volatile("s_waitcnt vmcnt(0)" ::: "memory");
        } else {
            XB_SPIN(xb_ld(&bar[XB_XGEN(b.x)]) == gen, bar);
            __builtin_amdgcn_fence(__ATOMIC_ACQUIRE, "agent");
            asm volatile("s_waitcnt vmcnt(0)" ::: "memory");
        }
    }
    __syncthreads();
}

enum { OP_PRO, OP_NORM, OP_GB0, OP_GB1, OP_GRES, OP_GGLU, OP_CONV, OP_POOL, OP_QKN, OP_ATT, OP_SSMA, OP_SSMB };

struct PhaseP { int op; const bf16* gA; const bf16* gB; int gN, gK, lda, ldb, agrp; bf16* ob; int oldc; const float* base; const float* scale; const unsigned* ssq_in; unsigned* ssq_out; bf16* xbo; bf16* vt; };
DI PhaseP phase_params(int ph, unsigned char* ws, CArgs* args, float* out) {
    bf16* Hb = (bf16*)(ws + WS_H); bf16* BIG = (bf16*)(ws + WS_BIG); bf16* BCV = (bf16*)(ws + WS_BCV); bf16* Gb = (bf16*)(ws + WS_G); bf16* Ub = (bf16*)(ws + WS_U);
        int op = OP_PRO;
        const bf16* gA = Hb; const bf16* gB = nullptr; int gN = D, gK = D, lda = D, ldb = D, agrp = 0;
        bf16* ob = nullptr; int oldc = D; const float* base = out; const float* scale = nullptr;
        unsigned* sqb = (unsigned*)(ws + WS_SSQ); const unsigned* ssq_in = sqb; unsigned* ssq_out = nullptr; bf16* xbo = Hb; bf16* vto = nullptr;
        const bf16* W1T = (const bf16*)(ws + WS_W1T); const bf16* W2T = (const bf16*)(ws + WS_W2T);
        switch (ph) {
            case 0: op = OP_PRO; break;
            case 1: op = OP_GB0; gB = (const bf16*)(ws + WS_CINT); gN = NQKV; ob = BCV; oldc = NQKV; ssq_in = sqb; break;
            case 2: op = OP_CONV; break;
            case 3: op = OP_GRES; gA = Gb; gB = (const bf16*)(ws + WS_COUTT); base = args->in[0]; ssq_out = sqb + 1 * S; break;
            case 4: op = OP_GB1; gB = W1T; gN = FF; ob = BIG; oldc = FF; ssq_in = sqb + 1 * S; break;
            case 5: op = OP_GRES; gA = BIG; gB = W2T; gK = FF; lda = FF; ldb = FF; ssq_out = sqb + 2 * S; break;
            case 6: op = OP_GB0; gB = (const bf16*)(ws + WS_PINT); gN = D; ob = Ub; oldc = D; ssq_in = sqb + 2 * S; break;
            case 7: op = OP_POOL; break;
            case 8: op = OP_GRES; gA = Gb; gB = (const bf16*)(ws + WS_PGT); gK = 512; ldb = 512; agrp = 512; scale = args->in[10]; ssq_out = sqb + 3 * S; break;
            case 9: op = OP_GB1; gB = W1T + (size_t)1 * D * FF; gN = FF; ob = BIG; oldc = FF; ssq_in = sqb + 3 * S; break;
            case 10: op = OP_GRES; gA = BIG; gB = W2T + (size_t)1 * D * FF; gK = FF; lda = FF; ldb = FF; ssq_out = sqb + 4 * S; break;
            case 11: op = OP_GB0; gB = (const bf16*)(ws + WS_QKVT); gN = NQKV; ob = BCV; oldc = NQKV; ssq_in = sqb + 4 * S; vto = (bf16*)(ws + WS_VT); break;
            case 12: op = OP_ATT; break;
            case 13: op = OP_GRES; gA = Gb; gB = (const bf16*)(ws + WS_AOUTT); ssq_out = sqb + 5 * S; break;
            case 14: op = OP_GB1; gB = W1T + (size_t)2 * D * FF; gN = FF; ob = BIG; oldc = FF; ssq_in = sqb + 5 * S; break;
            case 15: op = OP_GRES; gA = BIG; gB = W2T + (size_t)2 * D * FF; gK = FF; lda = FF; ldb = FF; ssq_out = sqb + 6 * S; break;
            case 16: op = OP_SSMA; break;
            case 17: op = OP_SSMB; break;
            case 18: op = OP_GGLU; gA = Gb; gB = (const bf16*)(ws + WS_GLUT); gN = 4096; ssq_out = sqb + 7 * S; break;
            case 19: op = OP_GB1; gB = W1T + (size_t)3 * D * FF; gN = FF; ob = BIG; oldc = FF; ssq_in = sqb + 7 * S; break;
            case 20: op = OP_GRES; gA = BIG; gB = W2T + (size_t)3 * D * FF; gK = FF; lda = FF; ldb = FF; xbo = nullptr; break;
            default: break;
        }
    PhaseP p; p.op = op; p.gA = gA; p.gB = gB; p.gN = gN; p.gK = gK; p.lda = lda; p.ldb = ldb; p.agrp = agrp; p.ob = ob; p.oldc = oldc; p.base = base; p.scale = scale; p.ssq_in = ssq_in; p.ssq_out = ssq_out; p.xbo = xbo; p.vt = vto;
    return p;
}


__global__ void __launch_bounds__(512, 2) fwd_megakernel(Args args_byval) {
    extern __shared__ __attribute__((aligned(16))) unsigned char lds_raw[];
    const int ph_lo = args_byval.ph_lo, ph_hi = args_byval.ph_hi;
    if (!MK_MULTI) {
        volatile LAS unsigned* st0 = (volatile LAS unsigned*)((LAS unsigned char*)lds_raw + LDS_BARST);
        if (threadIdx.x < 2) st0[threadIdx.x] = 0u;
        __syncthreads();
        (void)xcd_barrier_post((unsigned*)args_byval.ws, st0);
        if (ph_lo > 1000000) cg::this_grid().sync();
    }
    for (int ph = ph_lo; ph < ph_hi; ++ph) {
        asm volatile("" ::: "v24", "v25", "v26", "v27", "v28", "v29", "v30", "v31", "v32", "v33", "v34", "v35", "v36", "v37", "v38", "v39", "v40", "v41", "v42", "v43", "v44", "v45", "v46", "v47", "v48", "v49", "v50", "v51", "v52", "v53", "v54", "v55", "v56", "v57", "v58", "v59", "v60", "v61", "v62", "v63", "v64", "v65", "v66", "v67", "v68", "v69", "v70", "v71", "v72", "v73", "v74", "v75", "v76", "v77", "v78", "v79", "v80", "v81", "v82", "v83", "v84", "v85", "v86", "v87", "v88", "v89", "v90", "v91", "v92", "v93", "v94", "v95", "v96", "v97", "v98", "v99", "v100", "v101", "v102", "v103", "v104", "v105", "v106", "v107", "v108", "v109", "v110", "v111", "v112", "v113", "v114", "v115", "v116", "v117", "v118", "v119", "v120", "v121", "v122", "v123", "v124", "v125", "v126", "v127", "v128", "v129", "v130", "v131", "v132", "v133", "v134", "v135", "v136", "v137", "v138", "v139", "v140", "v141", "v142", "v143", "v144", "v145", "v146", "v147", "v148", "v149", "v150", "v151", "v152", "v153", "v154", "v155", "v156", "v157", "v158", "v159", "v160", "v161", "v162", "v163", "v164", "v165", "v166", "v167", "v168", "v169", "v170", "v171", "v172", "v173", "v174", "v175", "v176", "v177", "v178", "v179", "v180", "v181", "v182", "v183", "v184", "v185", "v186", "v187", "v188", "v189", "v190", "v191", "v192", "v193", "v194", "v195", "v196", "v197", "v198", "v199", "v200", "v201", "v202", "v203", "v204", "v205", "v206", "v207", "v208", "v209", "v210", "v211", "v212", "v213", "v214", "v215", "v216", "v217", "v218", "v219", "v220", "v221", "v222", "v223", "v224", "v225", "v226", "v227", "v228", "v229", "v230", "v231", "v232", "v233", "v234", "v235", "v236", "v237", "v238", "v239", "v240", "v241", "v242", "v243", "v244", "v245", "v246", "v247", "v248", "v249", "v250", "v251", "v252", "v253", "v254", "v255");
        CArgs* args = (CArgs*)__builtin_amdgcn_kernarg_segment_ptr(); asm volatile("" : "+s"(args));
        int tid = threadIdx.x; asm volatile("" : "+v"(tid));
        LAS unsigned char* lds = (LAS unsigned char*)lds_raw;
        const int lane = tid & 63, wave = __builtin_amdgcn_readfirstlane(tid >> 6);
        const int G = gridDim.x, gw = blockIdx.x * 8 + wave, NGW = G * 8, gtid = blockIdx.x * 512 + tid, nthr = G * 512;
        unsigned char* ws = args->ws;
        float* out = args->out;
        bf16* Hb = (bf16*)(ws + WS_H); bf16* BIG = (bf16*)(ws + WS_BIG); bf16* BCV = (bf16*)(ws + WS_BCV); bf16* Gb = (bf16*)(ws + WS_G); bf16* Ub = (bf16*)(ws + WS_U); bf16* VT = (bf16*)(ws + WS_VT);
        const int op = phase_params(ph, ws, args, out).op;
        unsigned* sqb = (unsigned*)(ws + WS_SSQ);
#define PP_GEMM() const PhaseP pp = phase_params(ph, ws, args, out); const pg8::Gemm g{pp.gA, pp.gB, S, pp.gN, pp.gK, pp.lda, pp.ldb, pp.agrp}; pg8::StaticOrder SO; SO.init(S, pp.gN, G, (int)blockIdx.x)
#define PP_RSTD() LAS float* rst = (LAS float*)(lds + 131072); \
        for (int i = 0; i < 4; ++i) { pg8::Unit uu; const bool has = SO.next(i, uu); \
            if (has && tid < 256) rst[i * 256 + tid] = 1.f / sqrtf((float)pp.ssq_in[uu.pm * 256 + tid] * (1.f / (1024.f * 2048.f)) + RMS_EPS); } \
        LDS_WAIT(); __syncthreads()
        switch (op) {
            case OP_PRO: if (OPMASK & (1 << OP_PRO)) prologue(args, lds, wave, lane, gw, NGW); break;
            case OP_GB0: if (OPMASK & (1 << OP_GB0)) { PP_GEMM(); PP_RSTD(); pg8::EpiBf16<0> E{pp.ob, pp.oldc, rst, pp.vt}; pg8::gemm_phase<pg8::EpiBf16<0>, pg8::StaticOrder, true, true>(lds, g, SO, E, tid); } break;
            case OP_GB1: if (OPMASK & (1 << OP_GB1)) { PP_GEMM(); PP_RSTD(); pg8::EpiBf16<1> E{pp.ob, pp.oldc, rst, nullptr}; pg8::gemm_phase<pg8::EpiBf16<1>, pg8::StaticOrder, true, true>(lds, g, SO, E, tid); } break;
            case OP_GRES: if (OPMASK & (1 << OP_GRES)) { PP_GEMM(); pg8::EpiRes E{pp.base, out, pp.scale, pp.xbo, pp.ssq_out}; pg8::gemm_phase<pg8::EpiRes, pg8::StaticOrder, false, true>(lds, g, SO, E, tid); } break;
            case OP_GGLU: if (OPMASK & (1 << OP_GGLU)) { PP_GEMM(); pg8::EpiGlu E{out, out, pp.xbo, pp.ssq_out}; pg8::gemm_phase<pg8::EpiGlu, pg8::StaticOrder, true, true>(lds, g, SO, E, tid); } break;
            case OP_CONV: if (OPMASK & (1 << OP_CONV)) conv_gate_phase(BCV, args->in[6], Gb, gtid, nthr); break;
            case OP_POOL: if (OPMASK & (1 << OP_POOL)) pool_phase(Ub, Gb, gtid, nthr); break;
            case OP_QKN: if (OPMASK & (1 << OP_QKN)) qknorm_phase(BCV, args->in[12], args->in[13], VT, lds, wave, lane, gw, NGW); break;
            case OP_ATT: if (OPMASK & (1 << OP_ATT)) attn_phase(BCV, VT, args->in[14], args->in[12], args->in[13], Gb, lds, tid, wave, lane); break;
            case OP_SSMA: if (OPMASK & (1 << OP_SSMA)) ssm_passA(Hb, sqb + 6 * S, args->in[1] + 3 * D, (const f32x2*)(ws + WS_ABAR), (const f32x2*)(ws + WS_BBAR), (f32x2*)(ws + WS_F), lane, gw, NGW); break;
            case OP_SSMB: if (OPMASK & (1 << OP_SSMB)) ssm_passB(Hb, sqb + 6 * S, args->in[1] + 3 * D, (const f32x2*)(ws + WS_ABAR), args->in[21], args->in[22], args->in[23], (const f32x2*)(ws + WS_F), (const bf16*)(ws + WS_KT), Gb, lds, tid, wave, lane); break;
            default: break;
        }
        if (ph + 1 < ph_hi) { XcdBarrier xb; xb.bar = (unsigned*)ws; xb.x = xb_xcc_id(); xb.st = (volatile LAS unsigned*)(lds + LDS_BARST); xcd_barrier(xb); }
    }
}

extern "C" void kernel_launch(void* const* d_in, const int* in_sizes, int n_in, void* d_out, int out_size, void* d_ws, size_t ws_size, hipStream_t stream) {
    static int grid = 0;
    if (grid == 0) {
        if (n_in != 25 || in_sizes[0] != S * D || out_size != S * D || ws_size < WS_END) { fprintf(stderr, "kernel_launch: unexpected shapes (n_in %d, in0 %d, out %d, ws %zu); nothing launched\n", n_in, n_in > 0 ? in_sizes[0] : -1, out_size, ws_size); grid = -1; return; }
        int dev = 0, cus = 0, per_cu = 0;
        hipGetDevice(&dev); hipDeviceGetAttribute(&cus, hipDeviceAttributeMultiprocessorCount, dev);
        if (hipFuncSetAttribute((const void*)fwd_megakernel, hipFuncAttributeMaxDynamicSharedMemorySize, LDS_BYTES) != hipSuccess) { fprintf(stderr, "kernel_launch: hipFuncSetAttribute failed\n"); grid = -1; return; }
        if (hipOccupancyMaxActiveBlocksPerMultiprocessor(&per_cu, (const void*)fwd_megakernel, 512, LDS_BYTES) != hipSuccess || per_cu < 1) { fprintf(stderr, "kernel_launch: occupancy query says %d blocks per CU\n", per_cu); per_cu = 1; }
        (void)hipGetLastError();
        grid = cus * per_cu;
        if (grid % 16 != 0 || grid < 16) grid = (grid / 16) * 16 > 0 ? (grid / 16) * 16 : 16;
    }
    if (grid < 0) return;
    Args a{};
    for (int i = 0; i < 25; ++i) a.in[i] = (const float*)d_in[i];
    a.out = (float*)d_out; a.ws = (unsigned char*)d_ws;
#if !MK_MULTI
    if (hipMemsetAsync((char*)d_ws + WS_CTL, 0, CTL_ZERO_BYTES, stream) != hipSuccess) { fprintf(stderr, "kernel_launch: memset failed\n"); return; }
#endif
#if MK_MULTI
    for (int ph = 0; ph < NPH; ++ph) { a.ph_lo = ph; a.ph_hi = ph + 1; hipLaunchKernelGGL(fwd_megakernel, dim3(grid), dim3(512), LDS_BYTES, stream, a); }
#else
    a.ph_lo = 0; a.ph_hi = NPH;
    void* kargs[] = {&a};
    hipError_t e = hipLaunchCooperativeKernel((const void*)fwd_megakernel, dim3(grid), dim3(512), kargs, LDS_BYTES, stream);
    if (e != hipSuccess) fprintf(stderr, "cooperative launch failed: %s (grid %d)\n", hipGetErrorString(e), grid);
#endif
}
```

```cpp
#include <hip/hip_runtime.h>
#include <hip/hip_cooperative_groups.h>
#include <cstdio>
#include <cstdint>
namespace cg = cooperative_groups;

#ifndef OPMASK
#define OPMASK 0xFFFF
#endif
#ifndef PROBE_LO
#define PROBE_LO 0
#define PROBE_HI 0
#endif
#ifndef MK_MULTI
#define MK_MULTI 0
#endif

namespace pg8 {
#define PG8_LAS __attribute__((address_space(3)))
typedef unsigned short bf16_t;
typedef short bf16x8 __attribute__((ext_vector_type(8)));
typedef float f32x4 __attribute__((ext_vector_type(4)));
typedef unsigned u32x4 __attribute__((ext_vector_type(4)));
constexpr int BM = 256, BK = 64, HALF = 128, HTB = HALF * BK * 2  , STAGE_BYTES = 8 * HTB, NXCD = 8, WGM = 8;

__host__ __device__ __forceinline__ int lds_byte(int r, int c) { const int st = (r >> 4) * 2 + (c >> 5), rr = r & 15, cc = c & 31, ob = rr * 64 + cc * 2; return st * 1024 + (ob ^ (((ob >> 9) & 1) << 5)); }
__host__ __device__ __forceinline__ void stage_rc(int b, int& R, int& C) { const int st = b / 1024, sb = b % 1024, swz = sb ^ (((sb >> 9) & 1) << 5); R = (st >> 1) * 16 + swz / 64; C = (st & 1) * 32 + (swz % 64) / 2; }
__host__ __device__ __forceinline__ int perm32(int rho) { const int n = rho >> 4, i = rho & 15; return 8 * (i >> 2) + 4 * n + (i & 3); }

struct Unit { int pm, pn, ord; };
struct Gemm { const bf16_t* A; const bf16_t* Bt; int M, N, K, lda, ldb, agrp; };

struct StaticOrder {
    static constexpr int nM = 8192 / BM; int nN, nwg, G, c;
    __host__ __device__ void init(int M, int N, int G_, int c_) { nN = N / BM; nwg = nM * nN; G = G_; c = c_; }
    __host__ __device__ bool next(int i, Unit& u) const {
        const long L = (long)i * G + c; if (L >= nwg) return false;
        int wgid = (int)L; { const int q = nwg / NXCD, r = nwg % NXCD, xcd = wgid % NXCD, off = wgid / NXCD; wgid = (xcd < r ? xcd * (q + 1) : r * (q + 1) + (xcd - r) * q) + off; }
        const int nig = WGM * nN, gid = wgid / nig, fm = gid * WGM, gsz = (nM - fm) < WGM ? (nM - fm) : WGM;
        u.pm = fm + ((wgid % nig) % gsz); u.pn = (wgid % nig) / gsz; u.ord = i; return true;
    }
    __device__ __forceinline__ void a_ready(const Unit&) const {}
    __device__ __forceinline__ void done(const Unit&) const {}
};

typedef float f32x2c __attribute__((ext_vector_type(2)));
typedef __bf16 bf16x2c __attribute__((ext_vector_type(2)));
__device__ __forceinline__ unsigned cvt_pk_bf16(float lo, float hi) { const f32x2c v = {lo, hi}; const bf16x2c b = __builtin_convertvector(v, bf16x2c); return __builtin_bit_cast(unsigned, b); }

template <int ACT  > struct EpiBf16 {
    static constexpr bool HAS_INIT = false;
    static constexpr bool PERM = true, AFTER_DRAIN = false;
    bf16_t* O; int ldc; const PG8_LAS float* rst; bf16_t* vt;
    __device__ __forceinline__ void operator()(const f32x4 (&acc)[2][2][4][2], const Unit& u, int wr, int wc, int fr, int fq) const {
        const int row0 = u.pm * BM + wr * 64 + fr, col0 = u.pn * BM + wc * 32 + 8 * fq;
        const PG8_LAS float* rsl = rst + (u.ord & 3) * 256 + wr * 64 + fr;
#pragma unroll
        for (int ai = 0; ai < 2; ++ai)
#pragma unroll
            for (int m = 0; m < 4; ++m) { bf16_t* rowp = O + (size_t)(row0 + ai * HALF + m * 16) * ldc + col0; const float rsv = rsl[ai * HALF + m * 16];
#pragma unroll
                for (int bj = 0; bj < 2; ++bj) { f32x4 v0 = acc[ai][bj][m][0] * rsv, v1 = acc[ai][bj][m][1] * rsv;
                    if (ACT == 1) {
#pragma unroll
                        for (int j = 0; j < 4; ++j) { const float a = fmaxf(v0[j], 0.f), b = fmaxf(v1[j], 0.f); v0[j] = a * a; v1[j] = b * b; } }
                    u32x4 w; w.x = cvt_pk_bf16(v0[0], v0[1]); w.y = cvt_pk_bf16(v0[2], v0[3]); w.z = cvt_pk_bf16(v1[0], v1[1]); w.w = cvt_pk_bf16(v1[2], v1[3]);
                    if (vt && u.pn >= 16) {
                        bf16_t* vp = vt + ((size_t)((2 * (u.pn - 16) + bj) * 128 + wc * 32 + 8 * fq)) * 8192 + (row0 + ai * HALF + m * 16);
                        vp[0 * 8192] = (bf16_t)(w.x & 0xffffu); vp[1 * 8192] = (bf16_t)(w.x >> 16); vp[2 * 8192] = (bf16_t)(w.y & 0xffffu); vp[3 * 8192] = (bf16_t)(w.y >> 16);
                        vp[4 * 8192] = (bf16_t)(w.z & 0xffffu); vp[5 * 8192] = (bf16_t)(w.z >> 16); vp[6 * 8192] = (bf16_t)(w.w & 0xffffu); vp[7 * 8192] = (bf16_t)(w.w >> 16);
                    } else *(u32x4*)(rowp + bj * HALF) = w; } }
    }
};
struct EpiRes {
    static constexpr bool PERM = true, AFTER_DRAIN = false, HAS_INIT = true;
    __device__ __forceinline__ void init(f32x4 (&acc)[2][2][4][2], const Unit& u, int wr, int wc, int fr, int fq) const {
        if (scale) return;
        const int row0 = u.pm * BM + wr * 64 + fr, col0 = u.pn * BM + wc * 32 + 8 * fq;
#pragma unroll
        for (int ai = 0; ai < 2; ++ai)
#pragma unroll
            for (int m = 0; m < 4; ++m) { const size_t off = (size_t)(row0 + ai * HALF + m * 16) * ldc + col0;
#pragma unroll
                for (int bj = 0; bj < 2; ++bj) { acc[ai][bj][m][0] = *(const f32x4*)(base + off + bj * HALF); acc[ai][bj][m][1] = *(const f32x4*)(base + off + bj * HALF + 4); } }
    }
    static constexpr int ldc = 2048; const float* base; float* out; const float* scale; bf16_t* xb; unsigned* ssq;
    __device__ __forceinline__ void operator()(const f32x4 (&acc)[2][2][4][2], const Unit& u, int wr, int wc, int fr, int fq) const {
        const int row0 = u.pm * BM + wr * 64 + fr, col0 = u.pn * BM + wc * 32 + 8 * fq;
        f32x4 sv[2][2];
#pragma unroll
        for (int bj = 0; bj < 2; ++bj)
#pragma unroll
            for (int n = 0; n < 2; ++n) sv[bj][n] = scale ? *(const f32x4*)(scale + col0 + bj * HALF + n * 4) : (f32x4){1.f, 1.f, 1.f, 1.f};
#pragma unroll
        for (int ai = 0; ai < 2; ++ai)
#pragma unroll
            for (int m = 0; m < 4; ++m) { const int row = row0 + ai * HALF + m * 16; const size_t off = (size_t)row * ldc + col0; float ss = 0.f;
#pragma unroll
                for (int bj = 0; bj < 2; ++bj) { f32x4 o0 = acc[ai][bj][m][0], o1 = acc[ai][bj][m][1];
                    if (scale) { const f32x4 b0 = *(const f32x4*)(base + off + bj * HALF), b1 = *(const f32x4*)(base + off + bj * HALF + 4); o0 = b0 + o0 * sv[bj][0]; o1 = b1 + o1 * sv[bj][1]; }
                    *(f32x4*)(out + off + bj * HALF) = o0; *(f32x4*)(out + off + bj * HALF + 4) = o1;
                    if (xb) { u32x4 w; w.x = cvt_pk_bf16(o0[0], o0[1]); w.y = cvt_pk_bf16(o0[2], o0[3]); w.z = cvt_pk_bf16(o1[0], o1[1]); w.w = cvt_pk_bf16(o1[2], o1[3]); *(u32x4*)(xb + off + bj * HALF) = w; }
                    ss += (o0[0] * o0[0] + o0[1] * o0[1]) + (o0[2] * o0[2] + o0[3] * o0[3]) + (o1[0] * o1[0] + o1[1] * o1[1]) + (o1[2] * o1[2] + o1[3] * o1[3]); }
                if (ssq) { ss += __shfl_xor(ss, 16); ss += __shfl_xor(ss, 32); if (fq == 0) atomicAdd(ssq + row, (unsigned)(ss * 1024.f + 0.5f)); }
                asm volatile("" ::: "memory"); }
    }
};
struct EpiGlu {
    static constexpr bool PERM = true, AFTER_DRAIN = false, HAS_INIT = false;
    static constexpr int ldc = 2048; const float* base; float* out; bf16_t* xb; unsigned* ssq;
    __device__ __forceinline__ void operator()(const f32x4 (&acc)[2][2][4][2], const Unit& u, int wr, int wc, int fr, int fq) const {
        const int row0 = u.pm * BM + wr * 64 + fr, col0 = u.pn * HALF + wc * 32 + 8 * fq;
#pragma unroll
        for (int ai = 0; ai < 2; ++ai)
#pragma unroll
            for (int m = 0; m < 4; ++m) { const int row = row0 + ai * HALF + m * 16; const size_t off = (size_t)row * ldc + col0; float ss = 0.f;
                f32x4 o[2];
#pragma unroll
                for (int n = 0; n < 2; ++n) { const f32x4 bs = *(const f32x4*)(base + off + n * 4); const f32x4 v = acc[ai][0][m][n], gt = acc[ai][1][m][n];
#pragma unroll
                    for (int j = 0; j < 4; ++j) { o[n][j] = bs[j] + v[j] / (1.f + __expf(-gt[j])); ss += o[n][j] * o[n][j]; }
                    *(f32x4*)(out + off + n * 4) = o[n]; }
                if (xb) { u32x4 w; w.x = cvt_pk_bf16(o[0][0], o[0][1]); w.y = cvt_pk_bf16(o[0][2], o[0][3]); w.z = cvt_pk_bf16(o[1][0], o[1][1]); w.w = cvt_pk_bf16(o[1][2], o[1][3]); *(u32x4*)(xb + off) = w; }
                if (ssq) { ss += __shfl_xor(ss, 16); ss += __shfl_xor(ss, 32); if (fq == 0) atomicAdd(ssq + row, (unsigned)(ss * 1024.f + 0.5f)); }
                asm volatile("" ::: "memory"); }
    }
};

template <class Epi, class Sched, bool ALIGN_EPI = false, bool SP2 = false>
__device__ __forceinline__ void gemm_phase(PG8_LAS unsigned char* lds, const Gemm g, const Sched& S, const Epi& E, const int tid_in) {
    const int tid = tid_in, wid = __builtin_amdgcn_readfirstlane(tid >> 6), lane = tid & 63, wr = wid >> 2, wc = wid & 3, fr = lane & 15, fq = lane >> 4;
    const int K = g.K, nt = K / BK;
    unsigned voffA[2], voffB[2];
#pragma unroll
    for (int i = 0; i < 2; ++i) { int R, C; stage_rc(tid * 16 + i * 8192, R, C); const int Rb = Epi::PERM ? ((R & ~31) + perm32(R & 31)) : R;
        voffA[i] = (unsigned)(R * g.lda + C) * 2u; voffB[i] = (unsigned)(Rb * g.ldb + C) * 2u; }
    const size_t kstep = (size_t)(BK * 2);
    const size_t hstepA = (size_t)HALF * g.lda * 2, hstepB = (size_t)HALF * g.ldb * 2;
    const size_t tstepA = 2 * hstepA, tstepB = 2 * hstepB;
    const unsigned ldsw = (unsigned)wid * 1024u;
    const int aoff = lds_byte(wr * 64 + fr, fq * 8), boff = lds_byte(wc * 32 + fr, fq * 8);
#define PG8_SA(b, h) (((b) * 2 + (h)) * HTB)
#define PG8_SB(b, h) ((4 + (b) * 2 + (h)) * HTB)
#define PG8_STAGE(bufoff, gbase, voff) do { _Pragma("unroll") for (int _i = 0; _i < 2; ++_i) \
        __builtin_amdgcn_global_load_lds((const unsigned*)((const char*)(gbase) + (voff)[_i]), (PG8_LAS unsigned*)(lds + (bufoff) + ldsw + _i * 8192), 16, 0, 0); } while (0)
#define PG8_LDA(dst, b, h) do { _Pragma("unroll") for (int m = 0; m < 4; ++m) _Pragma("unroll") for (int k = 0; k < 2; ++k) dst[m][k] = *(const PG8_LAS bf16x8*)(lds + PG8_SA(b, h) + aoff + m * 2048 + k * 1024); } while (0)
#define PG8_LDB(dst, b, h) do { _Pragma("unroll") for (int n = 0; n < 2; ++n) _Pragma("unroll") for (int k = 0; k < 2; ++k) dst[n][k] = *(const PG8_LAS bf16x8*)(lds + PG8_SB(b, h) + boff + n * 2048 + k * 1024); } while (0)
#define PG8_MMA(ai, bj, At, Bt) do { __builtin_amdgcn_s_setprio(1); _Pragma("unroll") for (int m = 0; m < 4; ++m) _Pragma("unroll") for (int n = 0; n < 2; ++n) _Pragma("unroll") for (int k = 0; k < 2; ++k) \
        acc[ai][bj][m][n] = __builtin_amdgcn_mfma_f32_16x16x32_bf16(Bt[n][k], At[m][k], acc[ai][bj][m][n], 0, 0, 0); __builtin_amdgcn_s_setprio(0); } while (0)
#define PG8_WAIT_V(n) asm volatile("s_waitcnt vmcnt(" #n ")" ::: "memory")
#define PG8_WAIT_L(n) asm volatile("s_waitcnt lgkmcnt(" #n ")" ::: "memory")
#define PG8_BAR __builtin_amdgcn_s_barrier()
#define PG8_SCHED __builtin_amdgcn_sched_barrier(0)
    Unit cur, nxt; int ui = 0;
    if (!S.next(0, cur)) return;
    f32x4 acc[2][2][4][2];
#pragma unroll
    for (int a = 0; a < 2; ++a)
#pragma unroll
        for (int b = 0; b < 2; ++b)
#pragma unroll
            for (int m = 0; m < 4; ++m)
#pragma unroll
                for (int n = 0; n < 2; ++n) acc[a][b][m][n] = (f32x4){0.f, 0.f, 0.f, 0.f};
    if constexpr (Epi::HAS_INIT) E.init(acc, cur, wr, wc, fr, fq);
    bf16x8 At[4][2], B0[2][2], B1[2][2];
    const char* cA = (const char*)g.A + (size_t)cur.pm * tstepA + (size_t)(cur.pn >> 1) * g.agrp * 2; const char* cB = (const char*)g.Bt + (size_t)cur.pn * tstepB;
    S.a_ready(cur);
    if constexpr (SP2) {
        PG8_STAGE(PG8_SB(0, 0), cB, voffB); PG8_STAGE(PG8_SB(0, 1), cB + hstepB, voffB); PG8_STAGE(PG8_SA(0, 0), cA, voffA); PG8_STAGE(PG8_SA(0, 1), cA + hstepA, voffA);
        if (wr == 1) PG8_BAR;
        PG8_WAIT_V(2); PG8_BAR;
        PG8_STAGE(PG8_SB(1, 0), cB + kstep, voffB); PG8_STAGE(PG8_SA(1, 0), cA + kstep, voffA); PG8_STAGE(PG8_SB(1, 1), cB + hstepB + kstep, voffB);
        PG8_WAIT_V(6); PG8_BAR;
    } else {
        PG8_STAGE(PG8_SB(0, 0), cB, voffB); PG8_STAGE(PG8_SA(0, 0), cA, voffA); PG8_STAGE(PG8_SB(0, 1), cB + hstepB, voffB); PG8_STAGE(PG8_SA(0, 1), cA + hstepA, voffA);
        if (wr == 1) PG8_BAR;
        PG8_WAIT_V(4); PG8_BAR;
        PG8_STAGE(PG8_SB(1, 0), cB + kstep, voffB); PG8_STAGE(PG8_SA(1, 0), cA + kstep, voffA); PG8_STAGE(PG8_SB(1, 1), cB + hstepB + kstep, voffB);
        PG8_WAIT_V(6); PG8_BAR;
    }
    for (;;) {
        const bool has_next = S.next(ui + 1, nxt);
        const char* nA = has_next ? (const char*)g.A + (size_t)nxt.pm * tstepA + (size_t)(nxt.pn >> 1) * g.agrp * 2 : cA; const char* nB = has_next ? (const char*)g.Bt + (size_t)nxt.pn * tstepB : cB;
        for (int t = 0; t < nt; t += 2) {
            const bool last = (t == nt - 2);
            const char* a1 = cA + (size_t)(t + 1) * kstep;
            const char* a2 = last ? nA : cA + (size_t)(t + 2) * kstep; const char* b2 = last ? nB : cB + (size_t)(t + 2) * kstep;
            const char* a3 = a2 + kstep; const char* b3 = b2 + kstep;
            if (last && has_next) S.a_ready(nxt);
            if constexpr (SP2) {
            PG8_LDB(B0, 0, 0); PG8_LDB(B1, 0, 1); PG8_SCHED; PG8_LDA(At, 0, 0); PG8_STAGE(PG8_SA(1, 1), a1 + hstepA, voffA);
            PG8_WAIT_V(8); PG8_WAIT_L(0); PG8_BAR; PG8_MMA(0, 0, At, B0); PG8_MMA(0, 1, At, B1); PG8_BAR; PG8_SCHED;
            PG8_LDA(At, 0, 1); PG8_STAGE(PG8_SB(0, 0), b2, voffB); PG8_STAGE(PG8_SB(0, 1), b2 + hstepB, voffB); PG8_STAGE(PG8_SA(0, 0), a2, voffA);
            PG8_WAIT_V(8); PG8_WAIT_L(0); PG8_BAR; PG8_MMA(1, 0, At, B0); PG8_MMA(1, 1, At, B1); PG8_BAR; PG8_SCHED;
            PG8_LDB(B0, 1, 0); PG8_LDB(B1, 1, 1); PG8_SCHED; PG8_LDA(At, 1, 0); PG8_STAGE(PG8_SA(0, 1), a2 + hstepA, voffA);
            PG8_WAIT_V(8); PG8_WAIT_L(0); PG8_BAR; PG8_MMA(0, 0, At, B0); PG8_MMA(0, 1, At, B1); PG8_BAR; PG8_SCHED;
            PG8_LDA(At, 1, 1); PG8_STAGE(PG8_SB(1, 0), b3, voffB); PG8_STAGE(PG8_SB(1, 1), b3 + hstepB, voffB); PG8_STAGE(PG8_SA(1, 0), a3, voffA);
            PG8_WAIT_V(8); PG8_WAIT_L(0); PG8_BAR; PG8_MMA(1, 0, At, B0); PG8_MMA(1, 1, At, B1); PG8_BAR; PG8_SCHED;
            } else {
            PG8_LDB(B0, 0, 0); PG8_SCHED; PG8_LDA(At, 0, 0); PG8_STAGE(PG8_SA(1, 1), a1 + hstepA, voffA);
            PG8_WAIT_L(8); PG8_BAR; PG8_WAIT_L(0); PG8_MMA(0, 0, At, B0); PG8_BAR; PG8_SCHED;
            PG8_LDB(B1, 0, 1); PG8_STAGE(PG8_SB(0, 0), b2, voffB);
            PG8_BAR; PG8_WAIT_L(0); PG8_MMA(0, 1, At, B1); PG8_BAR;
            PG8_LDA(At, 0, 1); PG8_STAGE(PG8_SA(0, 0), a2, voffA);
            PG8_BAR; PG8_WAIT_L(0); PG8_MMA(1, 0, At, B0); PG8_BAR; PG8_SCHED;
            PG8_STAGE(PG8_SB(0, 1), b2 + hstepB, voffB);
            PG8_WAIT_V(6); PG8_BAR; PG8_MMA(1, 1, At, B1); PG8_BAR;
            PG8_LDB(B0, 1, 0); PG8_SCHED; PG8_LDA(At, 1, 0); PG8_STAGE(PG8_SA(0, 1), a2 + hstepA, voffA);
            PG8_WAIT_L(8); PG8_BAR; PG8_WAIT_L(0); PG8_MMA(0, 0, At, B0); PG8_BAR; PG8_SCHED;
            PG8_LDB(B1, 1, 1); PG8_STAGE(PG8_SB(1, 0), b3, voffB);
            PG8_BAR; PG8_WAIT_L(0); PG8_MMA(0, 1, At, B1); PG8_BAR;
            PG8_LDA(At, 1, 1); PG8_STAGE(PG8_SA(1, 0), a3, voffA);
            PG8_BAR; PG8_WAIT_L(0); PG8_MMA(1, 0, At, B0); PG8_BAR; PG8_SCHED;
            PG8_STAGE(PG8_SB(1, 1), b3 + hstepB, voffB);
            PG8_WAIT_V(6); PG8_BAR; PG8_MMA(1, 1, At, B1); PG8_BAR;
            }
        }
        if constexpr (ALIGN_EPI) { if (wr == 0) PG8_BAR; }
        asm volatile("s_nop 7\n\ts_nop 7\n\ts_nop 7" ::: "memory");
        if constexpr (!Epi::AFTER_DRAIN) { E(acc, cur, wr, wc, fr, fq); S.done(cur); }
        if (!has_next) break;
#pragma unroll
        for (int a = 0; a < 2; ++a)
#pragma unroll
            for (int b = 0; b < 2; ++b)
#pragma unroll
                for (int m = 0; m < 4; ++m)
#pragma unroll
                    for (int n = 0; n < 2; ++n) acc[a][b][m][n] = (f32x4){0.f, 0.f, 0.f, 0.f};
        cur = nxt; cA = nA; cB = nB; ++ui;
        if constexpr (Epi::HAS_INIT) E.init(acc, cur, wr, wc, fr, fq);
        if constexpr (ALIGN_EPI) { if (wr == 1) PG8_BAR; }
    }
    PG8_WAIT_V(0);
    if constexpr (!ALIGN_EPI) { if (wr == 0) PG8_BAR; }
    PG8_BAR;
    if constexpr (Epi::AFTER_DRAIN) { E.fused(acc, cur, wr, wc, fr, fq, lds, wid, lane); S.done(cur); }
#undef PG8_SA
#undef PG8_SB
#undef PG8_STAGE
#undef PG8_LDA
#undef PG8_LDB
#undef PG8_MMA
#undef PG8_WAIT_V
#undef PG8_WAIT_L
#undef PG8_BAR
#undef PG8_SCHED
}
}

constexpr int S = 8192, D = 2048, FF = 8192, NQKV = 6144;
constexpr int NPH = 21;
constexpr float RMS_EPS = 1e-6f;
constexpr float LOG2E = 1.4426950408889634f;
constexpr float ATT_QSCALE = 0.08838834764831845f * LOG2E;

constexpr size_t MiB = 1u << 20;
constexpr size_t WS_CTL = 0, CTL_ZERO_BYTES = 65536;
constexpr size_t WS_W1T = 2 * MiB;
constexpr size_t WS_W2T = 130 * MiB;
constexpr size_t WS_CINT = 258 * MiB;
constexpr size_t WS_COUTT = 282 * MiB;
constexpr size_t WS_PINT = 290 * MiB;
constexpr size_t WS_PGT = 298 * MiB;
constexpr size_t WS_QKVT = 300 * MiB;
constexpr size_t WS_AOUTT = 324 * MiB;
constexpr size_t WS_GLUT = 332 * MiB;
constexpr size_t WS_ABAR = 348 * MiB;
constexpr size_t WS_BBAR = 349 * MiB;
constexpr size_t WS_F = 350 * MiB;
constexpr size_t WS_H = 358 * MiB;
constexpr size_t WS_BIG = 390 * MiB;
constexpr size_t WS_BCV = 518 * MiB;
constexpr size_t WS_G = 614 * MiB;
constexpr size_t WS_U = 646 * MiB;
constexpr size_t WS_VT = 678 * MiB;
constexpr size_t WS_DUMMY = 710 * MiB;
constexpr size_t WS_KT = 774 * MiB;
constexpr size_t WS_SSQ = 778 * MiB;
constexpr size_t WS_END = 779 * MiB;

constexpr int LDS_BYTES = 147456, LDS_BARST = 147456 - 64;

#define LAS __attribute__((address_space(3)))
#define DI __device__ __forceinline__
typedef unsigned short bf16;
typedef float f32x4 __attribute__((ext_vector_type(4)));
typedef float f32x2 __attribute__((ext_vector_type(2)));
typedef short bf16x8 __attribute__((ext_vector_type(8)));
typedef unsigned u32x4 __attribute__((ext_vector_type(4)));
typedef unsigned u32x2 __attribute__((ext_vector_type(2)));
#define LDS_WAIT() asm volatile("s_waitcnt lgkmcnt(0)" ::: "memory")
#define MFMA_SETTLE() asm volatile("s_nop 7\n\ts_nop 7\n\ts_nop 7" ::: "memory")
using pg8::cvt_pk_bf16;
DI float bf_lo(unsigned w) { return __uint_as_float(w << 16); }
DI float bf_hi(unsigned w) { return __uint_as_float(w & 0xffff0000u); }
DI float wave_sum(float v) {
#pragma unroll
    for (int o = 1; o < 64; o <<= 1) v += __shfl_xor(v, o);
    return v;
}

DI void transpose_item(const float* W, int K, int N, bf16* WT, int mode, const float* gain, LAS float* scr, int item, int lane) {
    const int nblk = N / 64, kb = item / nblk, nb = item % nblk, k0 = 64 * kb, n0 = 64 * nb;
    const int lk = lane >> 4, ln = (lane & 15) * 4;
#pragma unroll 8
    for (int i = 0; i < 16; ++i) { const int kk = 4 * i + lk; f32x4 v = __builtin_nontemporal_load((const f32x4*)(W + (size_t)(k0 + kk) * N + n0 + ln));
        if (gain) v = v * gain[k0 + kk];
        LAS float* d = scr + kk * 65 + ln; d[0] = v.x; d[1] = v.y; d[2] = v.z; d[3] = v.w; }
    LDS_WAIT(); asm volatile("" ::: "memory");
    int r0 = n0; if (mode == 1) { const int ch = n0 & 2047, half = n0 >> 11; r0 = 256 * (ch >> 7) + 128 * half + (ch & 127); }
    const int c = lane >> 3;
#pragma unroll
    for (int j = 0; j < 8; ++j) { const int n = (lane & 7) + 8 * j; const LAS float* s = scr + (8 * c) * 65 + n;
        u32x4 o; o.x = cvt_pk_bf16(s[0 * 65], s[1 * 65]); o.y = cvt_pk_bf16(s[2 * 65], s[3 * 65]); o.z = cvt_pk_bf16(s[4 * 65], s[5 * 65]); o.w = cvt_pk_bf16(s[6 * 65], s[7 * 65]);
        *(u32x4*)(WT + (size_t)(r0 + n) * K + k0 + 8 * c) = o; }
    LDS_WAIT(); asm volatile("" ::: "memory");
}

DI void xb_rows(const float* x, bf16* H, unsigned* ssq, int gw, int NGW, int lane) {
    for (int row = gw; row < S; row += NGW) {
        const float* xr = x + (size_t)row * D + lane * 8;
        bf16* hr = H + (size_t)row * D + lane * 8;
        float s = 0.f;
#pragma unroll
        for (int j = 0; j < 4; ++j) { const f32x4 a = *(const f32x4*)(xr + j * 512), b = *(const f32x4*)(xr + j * 512 + 4);
            s += (a.x * a.x + a.y * a.y) + (a.z * a.z + a.w * a.w) + (b.x * b.x + b.y * b.y) + (b.z * b.z + b.w * b.w);
            u32x4 o; o.x = cvt_pk_bf16(a.x, a.y); o.y = cvt_pk_bf16(a.z, a.w); o.z = cvt_pk_bf16(b.x, b.y); o.w = cvt_pk_bf16(b.z, b.w);
            *(u32x4*)(hr + j * 512) = o; }
        s = wave_sum(s);
        if (lane == 0) ssq[row] = (unsigned)(s * 1024.f + 0.5f);
    }
}

DI void ssm_ktab(const float* a_re, const float* a_im, const float* log_dt, const float* b_re, const float* b_im, const float* c_re, const float* c_im, unsigned short* Kt, LAS float* scr, int lane, int gw, int NGW);
DI void ssm_coef(const float* a_re, const float* a_im, const float* log_dt, int g, int n, f32x2& abar, f32x2& coef);
struct Args { const float* in[25]; float* out; unsigned char* ws; int ph_lo, ph_hi; };
typedef __attribute__((address_space(4))) const Args CArgs;

DI void prologue(CArgs* a, LAS unsigned char* lds, int wave, int lane, int gw, int NGW) {
    unsigned char* ws = a->ws;
    LAS float* scr = (LAS float*)(lds + wave * 16640);
    constexpr int I_W1 = (D / 64) * (FF / 64), I_W2 = (FF / 64) * (D / 64), I_C6 = (D / 64) * (NQKV / 64), I_DD = (D / 64) * (D / 64), I_PG = (512 / 64) * (512 / 64), I_GLU = (D / 64) * (4096 / 64);
    constexpr int NITEMS = 4 * I_W1 + 4 * I_W2 + 2 * I_C6 + 3 * I_DD + 4 * I_PG + I_GLU;
    for (int it = gw; it < NITEMS; it += NGW) {
        int r = it;
        if (r < 4 * I_W1) { const int l = r / I_W1; transpose_item(a->in[3] + (size_t)l * D * FF, D, FF, (bf16*)(ws + WS_W1T) + (size_t)l * D * FF, 0, a->in[2] + (size_t)l * D, scr, r % I_W1, lane); continue; } r -= 4 * I_W1;
        if (r < 4 * I_W2) { const int l = r / I_W2; transpose_item(a->in[4] + (size_t)l * D * FF, FF, D, (bf16*)(ws + WS_W2T) + (size_t)l * D * FF, 0, nullptr, scr, r % I_W2, lane); continue; } r -= 4 * I_W2;
        if (r < I_C6) { transpose_item(a->in[5], D, NQKV, (bf16*)(ws + WS_CINT), 0, a->in[1], scr, r, lane); continue; } r -= I_C6;
        if (r < I_C6) { transpose_item(a->in[11], D, NQKV, (bf16*)(ws + WS_QKVT), 0, a->in[1] + 2 * D, scr, r, lane); continue; } r -= I_C6;
        if (r < I_DD) { transpose_item(a->in[7], D, D, (bf16*)(ws + WS_COUTT), 0, nullptr, scr, r, lane); continue; } r -= I_DD;
        if (r < I_DD) { transpose_item(a->in[8], D, D, (bf16*)(ws + WS_PINT), 0, a->in[1] + D, scr, r, lane); continue; } r -= I_DD;
        if (r < I_DD) { transpose_item(a->in[15], D, D, (bf16*)(ws + WS_AOUTT), 0, nullptr, scr, r, lane); continue; } r -= I_DD;
        if (r < 4 * I_PG) { const int g = r / I_PG; transpose_item(a->in[9] + (size_t)g * 512 * 512, 512, 512, (bf16*)(ws + WS_PGT) + (size_t)g * 512 * 512, 0, nullptr, scr, r % I_PG, lane); continue; } r -= 4 * I_PG;
        transpose_item(a->in[24], D, 4096, (bf16*)(ws + WS_GLUT), 1, nullptr, scr, r, lane);
    }
    for (int i = gw * 64 + lane; i < 128 * 64; i += NGW * 64) {
        f32x2 ab, cf; ssm_coef(a->in[16], a->in[17], a->in[18], i >> 6, i & 63, ab, cf);
        ((f32x2*)(ws + WS_ABAR))[i] = ab;
        f32x2* bb = (f32x2*)(ws + WS_BBAR) + (size_t)i * 16;
        const float* br = a->in[19] + (size_t)i * 16; const float* bi = a->in[20] + (size_t)i * 16;
#pragma unroll
        for (int c = 0; c < 16; ++c) bb[c] = (f32x2){cf.x * br[c] - cf.y * bi[c], cf.x * bi[c] + cf.y * br[c]};
    }
    ssm_ktab(a->in[16], a->in[17], a->in[18], a->in[19], a->in[20], a->in[21], a->in[22], (bf16*)(ws + WS_KT), scr, lane, gw, NGW);
    { unsigned* sq = (unsigned*)(ws + WS_SSQ); for (int i = gw * 64 + lane; i < 7 * S; i += NGW * 64) sq[S + i] = 0u;
      xb_rows(a->in[0], (bf16*)(ws + WS_H), sq, gw, NGW, lane); }
}

DI void unpack8(const u32x4 w, float (&f)[8]) { f[0] = bf_lo(w.x); f[1] = bf_hi(w.x); f[2] = bf_lo(w.y); f[3] = bf_hi(w.y); f[4] = bf_lo(w.z); f[5] = bf_hi(w.z); f[6] = bf_lo(w.w); f[7] = bf_hi(w.w); }
DI u32x4 pack8(const float (&f)[8]) { u32x4 o; o.x = cvt_pk_bf16(f[0], f[1]); o.y = cvt_pk_bf16(f[2], f[3]); o.z = cvt_pk_bf16(f[4], f[5]); o.w = cvt_pk_bf16(f[6], f[7]); return o; }
DI f32x2 cmul(f32x2 a, f32x2 b) { return (f32x2){a.x * b.x - a.y * b.y, a.x * b.y + a.y * b.x}; }
DI bf16x8 pack8v(const float (&f)[8]) { const u32x4 o = pack8(f); return __builtin_bit_cast(bf16x8, o); }

DI void conv_gate_phase(const bf16* BCV, const float* cw, bf16* G, int gtid, int nthr) {
    for (int idx = gtid; idx < 256 * 512; idx += nthr) {
        const int c0 = (idx & 255) * 8, t0 = (idx >> 8) * 16;
        float w0[8], w1[8], w2[8], um1[8], um2[8];
#pragma unroll
        for (int e = 0; e < 8; ++e) { w0[e] = cw[c0 + e]; w1[e] = cw[D + c0 + e]; w2[e] = cw[2 * D + c0 + e]; um1[e] = 0.f; um2[e] = 0.f; }
        if (t0 >= 2) {
            float cgv[8], vv[8];
            const bf16* r2 = BCV + (size_t)(t0 - 2) * NQKV + c0; unpack8(*(const u32x4*)(r2 + D), cgv); unpack8(*(const u32x4*)(r2 + 2 * D), vv);
#pragma unroll
            for (int e = 0; e < 8; ++e) um2[e] = cgv[e] * vv[e];
            const bf16* r1 = BCV + (size_t)(t0 - 1) * NQKV + c0; unpack8(*(const u32x4*)(r1 + D), cgv); unpack8(*(const u32x4*)(r1 + 2 * D), vv);
#pragma unroll
            for (int e = 0; e < 8; ++e) um1[e] = cgv[e] * vv[e];
        }
        for (int t = t0; t < t0 + 16; ++t) {
            const bf16* r = BCV + (size_t)t * NQKV + c0;
            float bv[8], cgv[8], vv[8], o[8];
            unpack8(*(const u32x4*)(r), bv); unpack8(*(const u32x4*)(r + D), cgv); unpack8(*(const u32x4*)(r + 2 * D), vv);
#pragma unroll
            for (int e = 0; e < 8; ++e) { const float u = cgv[e] * vv[e]; o[e] = bv[e] * (w0[e] * um2[e] + w1[e] * um1[e] + w2[e] * u); um2[e] = um1[e]; um1[e] = u; }
            *(u32x4*)(G + (size_t)t * D + c0) = pack8(o);
        }
    }
}

DI void pool_phase(const bf16* U, bf16* G, int gtid, int nthr) {
    for (int idx = gtid; idx < 256 * 512; idx += nthr) {
        const int c0 = (idx & 255) * 8, t0 = (idx >> 8) * 16, w = 2 << (c0 >> 9);
        float sum[8];
#pragma unroll
        for (int e = 0; e < 8; ++e) sum[e] = 0.f;
        for (int j = 1; j < w; ++j) { const int t = t0 - j; if (t >= 0) { float f[8]; unpack8(*(const u32x4*)(U + (size_t)t * D + c0), f);
#pragma unroll
                for (int e = 0; e < 8; ++e) sum[e] += f[e]; } }
        for (int t = t0; t < t0 + 16; ++t) {
            float f[8], o[8]; unpack8(*(const u32x4*)(U + (size_t)t * D + c0), f);
            const float inv = 1.f / (float)((t + 1) < w ? (t + 1) : w);
#pragma unroll
            for (int e = 0; e < 8; ++e) { sum[e] += f[e]; o[e] = sum[e] * inv - f[e]; }
            *(u32x4*)(G + (size_t)t * D + c0) = pack8(o);
            const int tr = t - w + 1;
            if (tr >= 0) { float r[8]; unpack8(*(const u32x4*)(U + (size_t)tr * D + c0), r);
#pragma unroll
                for (int e = 0; e < 8; ++e) sum[e] -= r[e]; }
        }
    }
}

DI void qknorm_phase(bf16* QKV, const float* qg, const float* kg, bf16* VT, LAS unsigned char* lds, int wave, int lane, int gw, int NGW) {
    LAS unsigned char* tl = lds + wave * 17408;
    for (int tile = gw; tile < 128 * 16; tile += NGW) {
        const int h = tile & 15, c = tile >> 4, t0 = c * 64;
#pragma unroll
        for (int i = 0; i < 16; ++i) { const int pc = i * 64 + lane, t = pc >> 4, q = pc & 15;
            const u32x4 v = *(const u32x4*)(QKV + (size_t)(t0 + t) * NQKV + 2 * D + h * 128 + q * 8);
            *(LAS u32x4*)(tl + t * 272 + q * 16) = v; }
        LDS_WAIT(); asm volatile("" ::: "memory");
#pragma unroll
        for (int it = 0; it < 16; ++it) { const int d = lane + 64 * (it & 1), pp = it >> 1;
            unsigned short e[8];
#pragma unroll
            for (int k = 0; k < 8; ++k) e[k] = *(const LAS unsigned short*)(tl + (8 * pp + k) * 272 + d * 2);
            u32x4 o; o.x = e[0] | ((unsigned)e[1] << 16); o.y = e[2] | ((unsigned)e[3] << 16); o.z = e[4] | ((unsigned)e[5] << 16); o.w = e[6] | ((unsigned)e[7] << 16);
            *(u32x4*)(VT + (size_t)(h * 128 + d) * S + t0 + 8 * pp) = o; }
        LDS_WAIT(); asm volatile("" ::: "memory");
    }
}

DI void attn_phase(const bf16* QKV, const bf16* VT, const float* rel_bias, const float* qgain, const float* kgain, bf16* O, LAS unsigned char* lds, int tid, int wave, int lane) {
    constexpr int KROW = 272, VROW = 144, VOFF = 64 * KROW, BUF = VOFF + 128 * VROW;
    LAS float* btab = (LAS float*)(lds + 2 * BUF);
    const int fr = lane & 15, fq = lane >> 4;
    for (int wu = blockIdx.x; wu < 512; wu += gridDim.x) {
        const int h = wu & 15, c0 = (wu >> 4) * 4, c = c0 + (wave >> 1), qh = wave & 1;
        __syncthreads();
        for (int i = tid; i < 513; i += 512) btab[i] = rel_bias[h * 513 + i] * LOG2E;
        const int tq0 = 64 * c + 32 * qh;
        bf16x8 Qf[2][4];
#pragma unroll
        for (int qt = 0; qt < 2; ++qt)
#pragma unroll
            for (int ks = 0; ks < 4; ++ks) Qf[qt][ks] = *(const bf16x8*)(QKV + (size_t)(tq0 + 16 * qt + fr) * NQKV + h * 128 + 32 * ks + 8 * fq);
#pragma unroll
        for (int qt = 0; qt < 2; ++qt) { float qf[4][8]; float ss = 0.f;
#pragma unroll
            for (int ks = 0; ks < 4; ++ks) { unpack8(__builtin_bit_cast(u32x4, Qf[qt][ks]), qf[ks]);
#pragma unroll
                for (int e = 0; e < 8; ++e) ss += qf[ks][e] * qf[ks][e]; }
            ss += __shfl_xor(ss, 16); ss += __shfl_xor(ss, 32);
            const float rq = ATT_QSCALE / sqrtf(ss * (1.f / 128.f) + RMS_EPS);
#pragma unroll
            for (int ks = 0; ks < 4; ++ks) { const f32x4 g0 = *(const f32x4*)(qgain + 32 * ks + 8 * fq), g1 = *(const f32x4*)(qgain + 32 * ks + 8 * fq + 4);
                const float gg[8] = {g0.x, g0.y, g0.z, g0.w, g1.x, g1.y, g1.z, g1.w};
#pragma unroll
                for (int e = 0; e < 8; ++e) qf[ks][e] = qf[ks][e] * rq * gg[e];
                Qf[qt][ks] = pack8v(qf[ks]); } }
        f32x4 Oa[2][8];
#pragma unroll
        for (int qt = 0; qt < 2; ++qt)
#pragma unroll
            for (int dt = 0; dt < 8; ++dt) Oa[qt][dt] = (f32x4){0.f, 0.f, 0.f, 0.f};
        float mrun[2] = {-1e30f, -1e30f}, lrun[2] = {0.f, 0.f};
        const int kc_lo = (c0 - 8) > 0 ? (c0 - 8) : 0, kc_hi = c0 + 3;
        const bf16* kg = QKV + (size_t)(tid >> 4) * NQKV + D + h * 128 + (tid & 15) * 8;
        const bf16* vg = VT + (size_t)(h * 128 + (tid >> 3)) * S + (tid & 7) * 8;
        const int klds = (tid >> 4) * KROW + (tid & 15) * 16, vlds = VOFF + (tid >> 3) * VROW + (tid & 7) * 16;
        u32x4 kreg[2], vreg[2];
#define ATT_KNORM() do { const f32x4 g0 = *(const f32x4*)(kgain + (tid & 15) * 8), g1 = *(const f32x4*)(kgain + (tid & 15) * 8 + 4); const float gkk[8] = {g0.x, g0.y, g0.z, g0.w, g1.x, g1.y, g1.z, g1.w}; \
            _Pragma("unroll") for (int e = 0; e < 2; ++e) { float kf[8]; unpack8(kreg[e], kf); float ss = 0.f; \
            _Pragma("unroll") for (int k = 0; k < 8; ++k) ss += kf[k] * kf[k]; \
            ss += __shfl_xor(ss, 1); ss += __shfl_xor(ss, 2); ss += __shfl_xor(ss, 4); ss += __shfl_xor(ss, 8); \
            const float rk = 1.f / sqrtf(ss * (1.f / 128.f) + RMS_EPS); \
            _Pragma("unroll") for (int k = 0; k < 8; ++k) kf[k] = kf[k] * rk * gkk[k]; \
            kreg[e] = pack8(kf); } } while (0)
#pragma unroll
        for (int e = 0; e < 2; ++e) { kreg[e] = *(const u32x4*)(kg + (size_t)(64 * kc_lo + 32 * e) * NQKV); vreg[e] = *(const u32x4*)(vg + (size_t)(64 * e) * S + 64 * kc_lo); }
        ATT_KNORM();
#pragma unroll
        for (int e = 0; e < 2; ++e) { *(LAS u32x4*)(lds + klds + 32 * e * KROW) = kreg[e]; *(LAS u32x4*)(lds + vlds + 64 * e * VROW) = vreg[e]; }
        for (int kc = kc_lo; kc <= kc_hi; ++kc) {
            const int bo = ((kc - kc_lo) & 1) * BUF;
            if (kc < kc_hi) {
#pragma unroll
                for (int e = 0; e < 2; ++e) { kreg[e] = *(const u32x4*)(kg + (size_t)(64 * (kc + 1) + 32 * e) * NQKV); vreg[e] = *(const u32x4*)(vg + (size_t)(64 * e) * S + 64 * (kc + 1)); }
            }
            LDS_WAIT(); __syncthreads();
            if (kc >= c - 8 && kc <= c) {
#pragma unroll
                for (int bb = 0; bb < 2; ++bb) {
                    const int tk0 = 64 * kc + 32 * bb;
                    f32x4 sc[2][2];
#pragma unroll
                    for (int kt = 0; kt < 2; ++kt) { bf16x8 Kf[4];
#pragma unroll
                        for (int ks = 0; ks < 4; ++ks) Kf[ks] = *(const LAS bf16x8*)(lds + bo + (32 * bb + 8 * (fr >> 2) + 4 * kt + (fr & 3)) * KROW + (32 * ks + 8 * fq) * 2);
#pragma unroll
                        for (int qt = 0; qt < 2; ++qt) { f32x4 a = (f32x4){0.f, 0.f, 0.f, 0.f};
#pragma unroll
                            for (int ks = 0; ks < 4; ++ks) a = __builtin_amdgcn_mfma_f32_16x16x32_bf16(Kf[ks], Qf[qt][ks], a, 0, 0, 0);
                            sc[kt][qt] = a; } }
                    asm volatile("s_nop 7\n\ts_nop 7\n\ts_nop 7" : "+v"(sc[0][0]), "+v"(sc[0][1]), "+v"(sc[1][0]), "+v"(sc[1][1]));
                    asm volatile("s_nop 7" : "+v"(Oa[0][0]), "+v"(Oa[0][1]), "+v"(Oa[0][2]), "+v"(Oa[0][3]), "+v"(Oa[0][4]), "+v"(Oa[0][5]), "+v"(Oa[0][6]), "+v"(Oa[0][7]));
                    asm volatile("s_nop 7" : "+v"(Oa[1][0]), "+v"(Oa[1][1]), "+v"(Oa[1][2]), "+v"(Oa[1][3]), "+v"(Oa[1][4]), "+v"(Oa[1][5]), "+v"(Oa[1][6]), "+v"(Oa[1][7]));
                    bf16x8 Pf[2];
#pragma unroll
                    for (int qt = 0; qt < 2; ++qt) {
                        const int dbase = (tq0 + 16 * qt + fr) - (tk0 + 8 * fq);
                        float sv[8]; float mx = -1e30f;
#pragma unroll
                        for (int kt = 0; kt < 2; ++kt)
#pragma unroll
                            for (int r = 0; r < 4; ++r) { int dl = dbase - 4 * kt - r; dl = dl > 256 ? 256 : dl; const float v = sc[kt][qt][r] + btab[dl + 256]; sv[4 * kt + r] = v; mx = fmaxf(mx, v); }
                        mx = fmaxf(mx, __shfl_xor(mx, 16)); mx = fmaxf(mx, __shfl_xor(mx, 32));
                        const float mnew = fmaxf(mrun[qt], mx), alpha = __builtin_amdgcn_exp2f(mrun[qt] - mnew);
                        mrun[qt] = mnew;
                        float ps = 0.f;
#pragma unroll
                        for (int e = 0; e < 8; ++e) { sv[e] = __builtin_amdgcn_exp2f(sv[e] - mnew); ps += sv[e]; }
                        lrun[qt] = lrun[qt] * alpha + ps;
                        u32x4 pk; pk.x = cvt_pk_bf16(sv[0], sv[1]); pk.y = cvt_pk_bf16(sv[2], sv[3]); pk.z = cvt_pk_bf16(sv[4], sv[5]); pk.w = cvt_pk_bf16(sv[6], sv[7]);
                        Pf[qt] = __builtin_bit_cast(bf16x8, pk);
#pragma unroll
                        for (int dt = 0; dt < 8; ++dt) Oa[qt][dt] = Oa[qt][dt] * alpha;
                    }
                    asm volatile("s_nop 3" : "+v"(Pf[0]), "+v"(Pf[1]));
#pragma unroll
                    for (int dt = 0; dt < 8; ++dt) { const bf16x8 Vf = *(const LAS bf16x8*)(lds + bo + VOFF + (16 * dt + fr) * VROW + (32 * bb + 8 * fq) * 2);
#pragma unroll
                        for (int qt = 0; qt < 2; ++qt) Oa[qt][dt] = __builtin_amdgcn_mfma_f32_16x16x32_bf16(Vf, Pf[qt], Oa[qt][dt], 0, 0, 0); }
                }
            }
            if (kc < kc_hi) {
                ATT_KNORM();
#pragma unroll
                for (int e = 0; e < 2; ++e) { *(LAS u32x4*)(lds + (BUF - bo) + klds + 32 * e * KROW) = kreg[e]; *(LAS u32x4*)(lds + (BUF - bo) + vlds + 64 * e * VROW) = vreg[e]; }
            }
        }
#pragma unroll
        for (int qt = 0; qt < 2; ++qt) {
            float l = lrun[qt]; l += __shfl_xor(l, 16); l += __shfl_xor(l, 32);
            const float inv = 1.f / l;
            bf16* op = O + (size_t)(tq0 + 16 * qt + fr) * D + h * 128 + 4 * fq;
#pragma unroll
            for (int dt = 0; dt < 8; ++dt) { const f32x4 o = Oa[qt][dt] * inv; u32x2 w; w.x = cvt_pk_bf16(o.x, o.y); w.y = cvt_pk_bf16(o.z, o.w); *(u32x2*)(op + 16 * dt) = w; }
        }
    }
}

DI float gelu_tanh(float y) { const float t = 0.7978845608028654f * (y + 0.044715f * y * y * y); const float e = __expf(2.f * t); const float th = 1.f - 2.f / (e + 1.f); return 0.5f * y * (1.f + th); }

DI void ssm_coef(const float* a_re, const float* a_im, const float* log_dt, int g, int n, f32x2& abar, f32x2& coef) {
    const float dt = expf(log_dt[g]), lr = a_re[g * 64 + n], li = a_im[g * 64 + n];
    const float xr = lr * dt, yi = li * dt, ex = expf(xr), em1 = expm1f(xr);
    const float cy = cosf(yi), sy = sinf(yi), sh = sinf(0.5f * yi);
    const float ar = ex * cy, ai = ex * sy;
    const float pr = em1 * cy - 2.f * sh * sh, pi = ai;
    const float den = 1.f / (lr * lr + li * li);
    abar = (f32x2){ar, ai}; coef = (f32x2){(pr * lr + pi * li) * den, (pi * lr - pr * li) * den};
}
DI void ssm_ktab(const float* a_re, const float* a_im, const float* log_dt, const float* b_re, const float* b_im, const float* c_re, const float* c_im, bf16* Kt, LAS float* scr, int lane, int gw, int NGW) {
    const int fr = lane & 15, fq = lane >> 4;
    for (int u = gw; u < 128 * 16; u += NGW) {
        const int g = u >> 4, seg = u & 15;
#pragma unroll 1
        for (int idx = 0; idx < 16; ++idx) { const int n = 32 * (idx >> 3) + 8 * fq + (idx & 7);
            f32x2 av, cf; ssm_coef(a_re, a_im, log_dt, g, n, av, cf);
            const float rb = b_re[(size_t)(g * 64 + n) * 16 + fr], ib = b_im[(size_t)(g * 64 + n) * 16 + fr];
            *(LAS f32x4*)(scr + (idx * 64 + lane) * 4) = (f32x4){av.x, av.y, cf.x * rb - cf.y * ib, cf.x * ib + cf.y * rb}; }
        LDS_WAIT(); asm volatile("" ::: "memory");
        f32x2 a[16], p[16]; float br[16], bi[16];
#pragma unroll
        for (int idx = 0; idx < 16; ++idx) { const f32x4 t = *(const LAS f32x4*)(scr + (idx * 64 + lane) * 4);
            a[idx] = (f32x2){t.x, t.y}; br[idx] = t.z; bi[idx] = t.w;
            f32x2 pw = cmul(a[idx], a[idx]); pw = cmul(pw, pw);
            float one = 1.f; asm volatile("" : "+v"(one));
            f32x2 pp = (f32x2){one, 0.f};
#pragma unroll
            for (int bit = 0; bit < 4; ++bit) { if ((seg >> bit) & 1) pp = cmul(pp, pw); pw = cmul(pw, pw); }
            p[idx] = pp; }
        LDS_WAIT(); asm volatile("" ::: "memory");
        bf16x8 Cm[4];
#pragma unroll
        for (int ks = 0; ks < 4; ++ks) { const float* src = (ks < 2 ? c_re : c_im) + (size_t)(g * 16 + fr) * 64 + (ks & 1) * 32 + 8 * fq;
            const f32x4 x0 = *(const f32x4*)src, x1 = *(const f32x4*)(src + 4); const float sg = ks < 2 ? 1.f : -1.f;
            const float f[8] = {sg * x0.x, sg * x0.y, sg * x0.z, sg * x0.w, sg * x1.x, sg * x1.y, sg * x1.z, sg * x1.w};
            Cm[ks] = pack8v(f); }
        for (int tt = 0; tt < 4; ++tt) {
            const int tau = 4 * seg + tt;
            f32x4 acc = (f32x4){0.f, 0.f, 0.f, 0.f};
#pragma unroll
            for (int h = 0; h < 2; ++h) { float qr[8], qi[8];
#pragma unroll
                for (int e = 0; e < 8; ++e) { const int idx = 8 * h + e; qr[e] = p[idx].x * br[idx] - p[idx].y * bi[idx]; qi[e] = p[idx].y * br[idx] + p[idx].x * bi[idx]; }
                const bf16x8 fqr = pack8v(qr), fqi = pack8v(qi); MFMA_SETTLE();
                acc = __builtin_amdgcn_mfma_f32_16x16x32_bf16(Cm[h], fqr, acc, 0, 0, 0);
                acc = __builtin_amdgcn_mfma_f32_16x16x32_bf16(Cm[2 + h], fqi, acc, 0, 0, 0); }
            MFMA_SETTLE();
            bf16* kp = Kt + ((size_t)(g * 64 + tau) * 16 + 4 * fq) * 16 + fr;
#pragma unroll
            for (int r = 0; r < 4; ++r) kp[r * 16] = (bf16)(cvt_pk_bf16(acc[r], 0.f) & 0xffffu);
#pragma unroll
            for (int idx = 0; idx < 16; ++idx) p[idx] = cmul(p[idx], a[idx]);
        }
    }
}

DI void ssm_passA(const bf16* H, const unsigned* ssq, const float* gain, const f32x2* abar, const f32x2* bbar, f32x2* F, int lane, int gw, int NGW) {
    const int fr = lane & 15, fq = lane >> 4;
    bf16x8 Bb[8]; f32x2 a1[4], a16[4], lp[4]; float gq[8];
    int gprev = -1;
    for (int u = gw; u < 128 * 128; u += NGW) {
        const int g = u & 127, j = u >> 7;
        u32x4 uv[4]; float rsd[4];
#pragma unroll
        for (int i = 0; i < 4; ++i) { uv[i] = (u32x4){0u, 0u, 0u, 0u}; if (fq < 2) uv[i] = *(const u32x4*)(H + (size_t)(j * 64 + 16 * i + fr) * D + g * 16 + 8 * fq); rsd[i] = (float)ssq[j * 64 + 16 * i + fr] * (1.f / 1024.f); }
        if (g != gprev) {
            gprev = g;
#pragma unroll
            for (int e = 0; e < 8; ++e) gq[e] = gain[g * 16 + 8 * (fq & 1) + e];
#pragma unroll
            for (int q = 0; q < 4; ++q) { const int n = 16 * q + fr;
                float re[8], im[8];
#pragma unroll
                for (int e = 0; e < 8; ++e) { re[e] = 0.f; im[e] = 0.f; }
                if (fq < 2) { const f32x4* bp = (const f32x4*)(bbar + (size_t)(g * 64 + n) * 16 + 8 * fq);
#pragma unroll
                    for (int e = 0; e < 4; ++e) { const f32x4 t = bp[e]; re[2 * e] = t.x; im[2 * e] = t.y; re[2 * e + 1] = t.z; im[2 * e + 1] = t.w; } }
                Bb[q] = pack8v(re); Bb[q + 4] = pack8v(im);
                const f32x2 a = abar[g * 64 + n], a2 = cmul(a, a), a4 = cmul(a2, a2), a8 = cmul(a4, a4);
                a1[q] = a; a16[q] = cmul(a8, a8);
                float one = 1.f; asm volatile("" : "+v"(one));
                lp[q] = fq == 3 ? (f32x2){one, 0.f} : (fq == 2 ? a4 : (fq == 1 ? a8 : cmul(a8, a4))); }
        }
        f32x2 acc[4];
#pragma unroll
        for (int q = 0; q < 4; ++q) acc[q] = (f32x2){0.f, 0.f};
#pragma unroll
        for (int i = 0; i < 4; ++i) {
            float uf[8]; unpack8(uv[i], uf); const float rst = 1.f / sqrtf(rsd[i] * (1.f / D) + RMS_EPS);
#pragma unroll
            for (int e = 0; e < 8; ++e) uf[e] = uf[e] * rst * gq[e];
            const bf16x8 Ua = pack8v(uf);
            MFMA_SETTLE();
#pragma unroll
            for (int q = 0; q < 4; ++q) {
                const f32x4 z = (f32x4){0.f, 0.f, 0.f, 0.f};
                const f32x4 dr = __builtin_amdgcn_mfma_f32_16x16x32_bf16(Ua, Bb[q], z, 0, 0, 0), di = __builtin_amdgcn_mfma_f32_16x16x32_bf16(Ua, Bb[q + 4], z, 0, 0, 0);
                MFMA_SETTLE();
                f32x2 h = (f32x2){dr[0], di[0]};
#pragma unroll
                for (int r = 1; r < 4; ++r) { h = cmul(h, a1[q]); h.x += dr[r]; h.y += di[r]; }
                const f32x2 t = cmul(acc[q], a16[q]); acc[q] = (f32x2){t.x + h.x, t.y + h.y}; }
        }
#pragma unroll
        for (int q = 0; q < 4; ++q) { f32x2 f = cmul(acc[q], lp[q]);
            f.x += __shfl_xor(f.x, 16); f.x += __shfl_xor(f.x, 32); f.y += __shfl_xor(f.y, 16); f.y += __shfl_xor(f.y, 32);
            if (fq == 0) F[(size_t)j * 8192 + g * 64 + 16 * q + fr] = f; }
    }
}

DI void ssm_passB(const bf16* H, const unsigned* ssq, const float* gain, const f32x2* abar, const float* c_re, const float* c_im, const float* dsk, const f32x2* F, const bf16* Kt, bf16* Z, LAS unsigned char* lds, int tid, int wave, int lane) {
    const int fr = lane & 15, fq = lane >> 4, n = lane;
    LAS unsigned char* Kl = lds;
    LAS unsigned char* St = lds + 32768 + wave * 11264;
    LAS unsigned char* Uc = St + 8704;
    int gprev = -1, jdone = 0;
    f32x2 a = (f32x2){0.f, 0.f}, aL = a, carry = a; bf16x8 Cm[4]; f32x4 dd = (f32x4){0.f, 0.f, 0.f, 0.f}; float gq[8];
    for (int wu = blockIdx.x; wu < 2048; wu += gridDim.x) {
        const int g = wu & 127, j = (wu >> 7) * 8 + wave;
        if (g != gprev) {
            __syncthreads();
#pragma unroll
            for (int i = 0; i < 4; ++i) { const int idx = i * 512 + tid; *(LAS u32x4*)(Kl + idx * 16) = *(const u32x4*)(Kt + (size_t)g * 16384 + idx * 8); }
            a = abar[g * 64 + n]; aL = a;
#pragma unroll
            for (int q = 0; q < 6; ++q) aL = cmul(aL, aL);
#pragma unroll
            for (int ks = 0; ks < 4; ++ks) { const size_t o = (size_t)(g * 16 + fr) * 64 + 16 * ks + 4 * fq;
                const f32x4 cr = *(const f32x4*)(c_re + o), ci = *(const f32x4*)(c_im + o);
                const float f[8] = {cr.x, -ci.x, cr.y, -ci.y, cr.z, -ci.z, cr.w, -ci.w};
                Cm[ks] = pack8v(f); }
            dd = *(const f32x4*)(dsk + g * 16 + 4 * fq);
#pragma unroll
            for (int e = 0; e < 8; ++e) gq[e] = gain[g * 16 + 8 * (lane & 1) + e];
            carry = (f32x2){0.f, 0.f}; jdone = 0;
            LDS_WAIT(); __syncthreads();
            gprev = g;
        }
        if (j < jdone) { carry = (f32x2){0.f, 0.f}; jdone = 0; }
        { const f32x2* Fp = F + (size_t)g * 64 + n;
#pragma unroll 16
          for (int i = jdone; i < j; ++i) { const f32x2 f = Fp[(size_t)i * 8192]; const f32x2 t = cmul(carry, aL); carry = (f32x2){t.x + f.x, t.y + f.y}; }
          jdone = j; }
        f32x2 p = carry;
        { unsigned zr = 0u; asm volatile("" : "+v"(zr));
          if (lane < 32) *(LAS u32x4*)(Uc + lane * 16) = (u32x4){zr, zr, zr, zr}; }
#pragma unroll
        for (int e = 0; e < 2; ++e) { const int pc = lane + 64 * e, tok = pc >> 1, hf = pc & 1;
            float uf[8]; unpack8(*(const u32x4*)(H + (size_t)(j * 64 + tok) * D + g * 16 + 8 * hf), uf); const float rst = 1.f / sqrtf((float)ssq[j * 64 + tok] * (1.f / (1024.f * D)) + RMS_EPS);
#pragma unroll
            for (int k = 0; k < 8; ++k) uf[k] = uf[k] * rst * gq[k];
            *(LAS u32x4*)(Uc + (tok + 16) * 32 + hf * 16) = pack8(uf); }
        f32x4 acc[4];
#pragma unroll
        for (int hb = 0; hb < 2; ++hb) {
            for (int tt = 0; tt < 32; ++tt) { p = cmul(p, a); *(LAS unsigned*)(St + tt * 272 + n * 4) = cvt_pk_bf16(p.x, p.y); }
            LDS_WAIT(); asm volatile("" ::: "memory"); __builtin_amdgcn_wave_barrier();
#pragma unroll
            for (int ii = 0; ii < 2; ++ii) { f32x4 c4 = (f32x4){0.f, 0.f, 0.f, 0.f};
#pragma unroll
                for (int ks = 0; ks < 4; ++ks) { const bf16x8 Pf = *(const LAS bf16x8*)(St + (16 * ii + fr) * 272 + (32 * ks + 8 * fq) * 2); c4 = __builtin_amdgcn_mfma_f32_16x16x32_bf16(Cm[ks], Pf, c4, 0, 0, 0); }
                MFMA_SETTLE(); acc[2 * hb + ii] = c4; }
            LDS_WAIT(); asm volatile("" ::: "memory"); __builtin_amdgcn_wave_barrier();
        }
#pragma unroll
        for (int s = 0; s < 32; ++s) {
            const bf16x8 Af = *(const LAS bf16x8*)(Kl + (2 * s + (fq >> 1)) * 512 + fr * 32 + (fq & 1) * 16);
#pragma unroll
            for (int i = 0; i < 4; ++i) if (i >= (s >> 3)) {
                const int row = 16 * i + fr - (2 * s + (fq >> 1));
                const bf16x8 Bf = *(const LAS bf16x8*)(Uc + (row + 16) * 32 + (fq & 1) * 16);
                acc[i] = __builtin_amdgcn_mfma_f32_16x16x32_bf16(Af, Bf, acc[i], 0, 0, 0); }
        }
        MFMA_SETTLE();
#pragma unroll
        for (int i = 0; i < 4; ++i) {
            const u32x2 hv = *(const LAS u32x2*)(Uc + (16 * i + fr + 16) * 32 + fq * 8);
            const f32x4 uv = (f32x4){bf_lo(hv.x), bf_hi(hv.x), bf_lo(hv.y), bf_hi(hv.y)};
            const f32x4 y = acc[i] + dd * uv;
            u32x2 w; w.x = cvt_pk_bf16(gelu_tanh(y.x), gelu_tanh(y.y)); w.y = cvt_pk_bf16(gelu_tanh(y.z), gelu_tanh(y.w));
            *(u32x2*)(Z + (size_t)(j * 64 + 16 * i + fr) * D + g * 16 + 4 * fq) = w; }
        LDS_WAIT(); asm volatile("" ::: "memory"); __builtin_amdgcn_wave_barrier();
    }
}

#define XB_TMO      128
#define XB_XCNT(j)  (256  + 64 * (j))
#define XB_XSUB(j)  (1280 + 64 * (j))
#define XB_XGEN(j)  (2304 + 64 * (j))
#define XB_TOP      3328
#define XB_TOPGEN   3392
#define XCD_BAR_WORDS 3456
#define XB_SPIN_CAP (1u << 18)

__device__ __forceinline__ unsigned xb_ld(unsigned* p)              { return __hip_atomic_load(p, __ATOMIC_RELAXED, __HIP_MEMORY_SCOPE_AGENT); }
__device__ __forceinline__ unsigned xb_add(unsigned* p, unsigned v) { return __hip_atomic_fetch_add(p, v, __ATOMIC_RELAXED, __HIP_MEMORY_SCOPE_AGENT); }
__device__ __forceinline__ unsigned xb_xcc_id() { return (unsigned)__builtin_amdgcn_s_getreg((3 << 11) | 20) & 0xFu; }
#define XB_SPIN(cond, bar) do { unsigned _sp = 0; while (cond) { __builtin_amdgcn_s_sleep(1); \
    if ((++_sp & 255u) == 0u) { if (xb_ld(&(bar)[XB_TMO])) break; if (_sp > XB_SPIN_CAP) { atomicAdd(&(bar)[XB_TMO], 1u); break; } } } } while (0)

struct XcdBarrier {
    unsigned* bar; unsigned x;
    volatile LAS unsigned* st;
};

__device__ __forceinline__ XcdBarrier xcd_barrier_post(unsigned* bar, volatile LAS unsigned* st) {
    XcdBarrier b; b.bar = bar; b.x = xb_xcc_id(); b.st = st;
    if (threadIdx.x == 0) (void)xb_add(&bar[XB_XCNT(b.x)], 1u);
    return b;
}
__device__ __forceinline__ void xcd_barrier_complete(unsigned* bar, unsigned x, unsigned& nloc, unsigned& nx) {
    const unsigned G = gridDim.x * gridDim.y * gridDim.z;
    unsigned sum, cnt, mine, sp = 0u;
    for (;;) {
        sum = 0u; cnt = 0u; mine = 0u;
#pragma unroll
        for (unsigned j = 0; j < 16; ++j) { const unsigned c = xb_ld(&bar[XB_XCNT(j)]); sum += c; cnt += (c > 0u) ? 1u : 0u; mine = (j == x) ? c : mine; }
        if (sum == G) break;
        __builtin_amdgcn_s_sleep(1);
        if ((++sp & 255u) == 0u) { if (xb_ld(&bar[XB_TMO])) break; if (sp > XB_SPIN_CAP) { atomicAdd(&bar[XB_TMO], 1u); break; } }
    }
    nloc = mine > 0u ? mine : 1u; nx = cnt > 0u ? cnt : 1u;
}

__device__ __forceinline__ void xcd_barrier(const XcdBarrier& b) {
    asm volatile("s_waitcnt vmcnt(0)" ::: "memory");
    __syncthreads();
    if (threadIdx.x == 0) {
        unsigned* bar = b.bar;
        __builtin_amdgcn_s_waitcnt(0);
        unsigned nloc = b.st[0], nx = b.st[1];
        if (nloc == 0u) { xcd_barrier_complete(bar, b.x, nloc, nx); b.st[0] = nloc; b.st[1] = nx; }
        const unsigned old = xb_add(&bar[XB_XSUB(b.x)], 1u);
        const unsigned gen = old / nloc;
        if (old + 1u == (gen + 1u) * nloc) {
            __builtin_amdgcn_fence(__ATOMIC_RELEASE, "agent");
            asm volatile("s_waitcnt vmcnt(0)" ::: "memory");
            const unsigned og = xb_add(&bar[XB_TOP], 1u);
            const unsigned tg = og / nx;
            if (og + 1u == (tg + 1u) * nx) xb_add(&bar[XB_TOPGEN], 1u);
            else XB_SPIN(xb_ld(&bar[XB_TOPGEN]) == tg, bar);
            __builtin_amdgcn_fence(__ATOMIC_ACQUIRE, "agent");
            xb_add(&bar[XB_XGEN(b.x)], 1u);
            asm volatile("s_waitcnt vmcnt(0)" ::: "memory");
        } else {
            XB_SPIN(xb_ld(&bar[XB_XGEN(b.x)]) == gen, bar);
            __builtin_amdgcn_fence(__ATOMIC_ACQUIRE, "agent");
            asm volatile("s_waitcnt vmcnt(0)" ::: "memory");
        }
    }
    __syncthreads();
}

enum { OP_PRO, OP_NORM, OP_GB0, OP_GB1, OP_GRES, OP_GGLU, OP_CONV, OP_POOL, OP_QKN, OP_ATT, OP_SSMA, OP_SSMB };

struct PhaseP { int op; const bf16* gA; const bf16* gB; int gN, gK, lda, ldb, agrp; bf16* ob; int oldc; const float* base; const float* scale; const unsigned* ssq_in; unsigned* ssq_out; bf16* xbo; bf16* vt; };
DI PhaseP phase_params(int ph, unsigned char* ws, CArgs* args, float* out) {
    bf16* Hb = (bf16*)(ws + WS_H); bf16* BIG = (bf16*)(ws + WS_BIG); bf16* BCV = (bf16*)(ws + WS_BCV); bf16* Gb = (bf16*)(ws + WS_G); bf16* Ub = (bf16*)(ws + WS_U);
        int op = OP_PRO;
        const bf16* gA = Hb; const bf16* gB = nullptr; int gN = D, gK = D, lda = D, ldb = D, agrp = 0;
        bf16* ob = nullptr; int oldc = D; const float* base = out; const float* scale = nullptr;
        unsigned* sqb = (unsigned*)(ws + WS_SSQ); const unsigned* ssq_in = sqb; unsigned* ssq_out = nullptr; bf16* xbo = Hb; bf16* vto = nullptr;
        const bf16* W1T = (const bf16*)(ws + WS_W1T); const bf16* W2T = (const bf16*)(ws + WS_W2T);
        switch (ph) {
            case 0: op = OP_PRO; break;
            case 1: op = OP_GB0; gB = (const bf16*)(ws + WS_CINT); gN = NQKV; ob = BCV; oldc = NQKV; ssq_in = sqb; break;
            case 2: op = OP_CONV; break;
            case 3: op = OP_GRES; gA = Gb; gB = (const bf16*)(ws + WS_COUTT); base = args->in[0]; ssq_out = sqb + 1 * S; break;
            case 4: op = OP_GB1; gB = W1T; gN = FF; ob = BIG; oldc = FF; ssq_in = sqb + 1 * S; break;
            case 5: op = OP_GRES; gA = BIG; gB = W2T; gK = FF; lda = FF; ldb = FF; ssq_out = sqb + 2 * S; break;
            case 6: op = OP_GB0; gB = (const bf16*)(ws + WS_PINT); gN = D; ob = Ub; oldc = D; ssq_in = sqb + 2 * S; break;
            case 7: op = OP_POOL; break;
            case 8: op = OP_GRES; gA = Gb; gB = (const bf16*)(ws + WS_PGT); gK = 512; ldb = 512; agrp = 512; scale = args->in[10]; ssq_out = sqb + 3 * S; break;
            case 9: op = OP_GB1; gB = W1T + (size_t)1 * D * FF; gN = FF; ob = BIG; oldc = FF; ssq_in = sqb + 3 * S; break;
            case 10: op = OP_GRES; gA = BIG; gB = W2T + (size_t)1 * D * FF; gK = FF; lda = FF; ldb = FF; ssq_out = sqb + 4 * S; break;
            case 11: op = OP_GB0; gB = (const bf16*)(ws + WS_QKVT); gN = NQKV; ob = BCV; oldc = NQKV; ssq_in = sqb + 4 * S; vto = (bf16*)(ws + WS_VT); break;
            case 12: op = OP_ATT; break;
            case 13: op = OP_GRES; gA = Gb; gB = (const bf16*)(ws + WS_AOUTT); ssq_out = sqb + 5 * S; break;
            case 14: op = OP_GB1; gB = W1T + (size_t)2 * D * FF; gN = FF; ob = BIG; oldc = FF; ssq_in = sqb + 5 * S; break;
            case 15: op = OP_GRES; gA = BIG; gB = W2T + (size_t)2 * D * FF; gK = FF; lda = FF; ldb = FF; ssq_out = sqb + 6 * S; break;
            case 16: op = OP_SSMA; break;
            case 17: op = OP_SSMB; break;
            case 18: op = OP_GGLU; gA = Gb; gB = (const bf16*)(ws + WS_GLUT); gN = 4096; ssq_out = sqb + 7 * S; break;
            case 19: op = OP_GB1; gB = W1T + (size_t)3 * D * FF; gN = FF; ob = BIG; oldc = FF; ssq_in = sqb + 7 * S; break;
            case 20: op = OP_GRES; gA = BIG; gB = W2T + (size_t)3 * D * FF; gK = FF; lda = FF; ldb = FF; xbo = nullptr; break;
            default: break;
        }
    PhaseP p; p.op = op; p.gA = gA; p.gB = gB; p.gN = gN; p.gK = gK; p.lda = lda; p.ldb = ldb; p.agrp = agrp; p.ob = ob; p.oldc = oldc; p.base = base; p.scale = scale; p.ssq_in = ssq_in; p.ssq_out = ssq_out; p.xbo = xbo; p.vt = vto;
    return p;
}


__global__ void __launch_bounds__(512, 2) fwd_megakernel(Args args_byval) {
    extern __shared__ __attribute__((aligned(16))) unsigned char lds_raw[];
    const int ph_lo = args_byval.ph_lo, ph_hi = args_byval.ph_hi;
    if (!MK_MULTI) {
        volatile LAS unsigned* st0 = (volatile LAS unsigned*)((LAS unsigned char*)lds_raw + LDS_BARST);
        if (threadIdx.x < 2) st0[threadIdx.x] = 0u;
        __syncthreads();
        (void)xcd_barrier_post((unsigned*)args_byval.ws, st0);
        if (ph_lo > 1000000) cg::this_grid().sync();
    }
    for (int ph = ph_lo; ph < ph_hi; ++ph) {
        asm volatile("" ::: "v24", "v25", "v26", "v27", "v28", "v29", "v30", "v31", "v32", "v33", "v34", "v35", "v36", "v37", "v38", "v39", "v40", "v41", "v42", "v43", "v44", "v45", "v46", "v47", "v48", "v49", "v50", "v51", "v52", "v53", "v54", "v55", "v56", "v57", "v58", "v59", "v60", "v61", "v62", "v63", "v64", "v65", "v66", "v67", "v68", "v69", "v70", "v71", "v72", "v73", "v74", "v75", "v76", "v77", "v78", "v79", "v80", "v81", "v82", "v83", "v84", "v85", "v86", "v87", "v88", "v89", "v90", "v91", "v92", "v93", "v94", "v95", "v96", "v97", "v98", "v99", "v100", "v101", "v102", "v103", "v104", "v105", "v106", "v107", "v108", "v109", "v110", "v111", "v112", "v113", "v114", "v115", "v116", "v117", "v118", "v119", "v120", "v121", "v122", "v123", "v124", "v125", "v126", "v127", "v128", "v129", "v130", "v131", "v132", "v133", "v134", "v135", "v136", "v137", "v138", "v139", "v140", "v141", "v142", "v143", "v144", "v145", "v146", "v147", "v148", "v149", "v150", "v151", "v152", "v153", "v154", "v155", "v156", "v157", "v158", "v159", "v160", "v161", "v162", "v163", "v164", "v165", "v166", "v167", "v168", "v169", "v170", "v171", "v172", "v173", "v174", "v175", "v176", "v177", "v178", "v179", "v180", "v181", "v182", "v183", "v184", "v185", "v186", "v187", "v188", "v189", "v190", "v191", "v192", "v193", "v194", "v195", "v196", "v197", "v198", "v199", "v200", "v201", "v202", "v203", "v204", "v205", "v206", "v207", "v208", "v209", "v210", "v211", "v212", "v213", "v214", "v215", "v216", "v217", "v218", "v219", "v220", "v221", "v222", "v223", "v224", "v225", "v226", "v227", "v228", "v229", "v230", "v231", "v232", "v233", "v234", "v235", "v236", "v237", "v238", "v239", "v240", "v241", "v242", "v243", "v244", "v245", "v246", "v247", "v248", "v249", "v250", "v251", "v252", "v253", "v254", "v255");
        CArgs* args = (CArgs*)__builtin_amdgcn_kernarg_segment_ptr(); asm volatile("" : "+s"(args));
        int tid = threadIdx.x; asm volatile("" : "+v"(tid));
        LAS unsigned char* lds = (LAS unsigned char*)lds_raw;
        const int lane = tid & 63, wave = __builtin_amdgcn_readfirstlane(tid >> 6);
        const int G = gridDim.x, gw = blockIdx.x * 8 + wave, NGW = G * 8, gtid = blockIdx.x * 512 + tid, nthr = G * 512;
        unsigned char* ws = args->ws;
        float* out = args->out;
        bf16* Hb = (bf16*)(ws + WS_H); bf16* BIG = (bf16*)(ws + WS_BIG); bf16* BCV = (bf16*)(ws + WS_BCV); bf16* Gb = (bf16*)(ws + WS_G); bf16* Ub = (bf16*)(ws + WS_U); bf16* VT = (bf16*)(ws + WS_VT);
        const int op = phase_params(ph, ws, args, out).op;
        unsigned* sqb = (unsigned*)(ws + WS_SSQ);
#define PP_GEMM() const PhaseP pp = phase_params(ph, ws, args, out); const pg8::Gemm g{pp.gA, pp.gB, S, pp.gN, pp.gK, pp.lda, pp.ldb, pp.agrp}; pg8::StaticOrder SO; SO.init(S, pp.gN, G, (int)blockIdx.x)
#define PP_RSTD() LAS float* rst = (LAS float*)(lds + 131072); \
        for (int i = 0; i < 4; ++i) { pg8::Unit uu; const bool has = SO.next(i, uu); \
            if (has && tid < 256) rst[i * 256 + tid] = 1.f / sqrtf((float)pp.ssq_in[uu.pm * 256 + tid] * (1.f / (1024.f * 2048.f)) + RMS_EPS); } \
        LDS_WAIT(); __syncthreads()
        switch (op) {
            case OP_PRO: if (OPMASK & (1 << OP_PRO)) prologue(args, lds, wave, lane, gw, NGW); break;
            case OP_GB0: if (OPMASK & (1 << OP_GB0)) { PP_GEMM(); PP_RSTD(); pg8::EpiBf16<0> E{pp.ob, pp.oldc, rst, pp.vt}; pg8::gemm_phase<pg8::EpiBf16<0>, pg8::StaticOrder, true, true>(lds, g, SO, E, tid); } break;
            case OP_GB1: if (OPMASK & (1 << OP_GB1)) { PP_GEMM(); PP_RSTD(); pg8::EpiBf16<1> E{pp.ob, pp.oldc, rst, nullptr}; pg8::gemm_phase<pg8::EpiBf16<1>, pg8::StaticOrder, true, true>(lds, g, SO, E, tid); } break;
            case OP_GRES: if (OPMASK & (1 << OP_GRES)) { PP_GEMM(); pg8::EpiRes E{pp.base, out, pp.scale, pp.xbo, pp.ssq_out}; pg8::gemm_phase<pg8::EpiRes, pg8::StaticOrder, false, true>(lds, g, SO, E, tid); } break;
            case OP_GGLU: if (OPMASK & (1 << OP_GGLU)) { PP_GEMM(); pg8::EpiGlu E{out, out, pp.xbo, pp.ssq_out}; pg8::gemm_phase<pg8::EpiGlu, pg8::StaticOrder, true, true>(lds, g, SO, E, tid); } break;
            case OP_CONV: if (OPMASK & (1 << OP_CONV)) conv_gate_phase(BCV, args->in[6], Gb, gtid, nthr); break;
            case OP_POOL: if (OPMASK & (1 << OP_POOL)) pool_phase(Ub, Gb, gtid, nthr); break;
            case OP_QKN: if (OPMASK & (1 << OP_QKN)) qknorm_phase(BCV, args->in[12], args->in[13], VT, lds, wave, lane, gw, NGW); break;
            case OP_ATT: if (OPMASK & (1 << OP_ATT)) attn_phase(BCV, VT, args->in[14], args->in[12], args->in[13], Gb, lds, tid, wave, lane); break;
            case OP_SSMA: if (OPMASK & (1 << OP_SSMA)) ssm_passA(Hb, sqb + 6 * S, args->in[1] + 3 * D, (const f32x2*)(ws + WS_ABAR), (const f32x2*)(ws + WS_BBAR), (f32x2*)(ws + WS_F), lane, gw, NGW); break;
            case OP_SSMB: if (OPMASK & (1 << OP_SSMB)) ssm_passB(Hb, sqb + 6 * S, args->in[1] + 3 * D, (const f32x2*)(ws + WS_ABAR), args->in[21], args->in[22], args->in[23], (const f32x2*)(ws + WS_F), (const bf16*)(ws + WS_KT), Gb, lds, tid, wave, lane); break;
            default: break;
        }
        if (ph + 1 < ph_hi) { XcdBarrier xb; xb.bar = (unsigned*)ws; xb.x = xb_xcc_id(); xb.st = (volatile LAS unsigned*)(lds + LDS_BARST); xcd_barrier(xb); }
    }
}

extern "C" void kernel_launch(void* const* d_in, const int* in_sizes, int n_in, void* d_out, int out_size, void* d_ws, size_t ws_size, hipStream_t stream) {
    static int grid = 0;
    if (grid == 0) {
        if (n_in != 25 || in_sizes[0] != S * D || out_size != S * D || ws_size < WS_END) { fprintf(stderr, "kernel_launch: unexpected shapes (n_in %d, in0 %d, out %d, ws %zu); nothing launched\n", n_in, n_in > 0 ? in_sizes[0] : -1, out_size, ws_size); grid = -1; return; }
        int dev = 0, cus = 0, per_cu = 0;
        hipGetDevice(&dev); hipDeviceGetAttribute(&cus, hipDeviceAttributeMultiprocessorCount, dev);
        if (hipFuncSetAttribute((const void*)fwd_megakernel, hipFuncAttributeMaxDynamicSharedMemorySize, LDS_BYTES) != hipSuccess) { fprintf(stderr, "kernel_launch: hipFuncSetAttribute failed\n"); grid = -1; return; }
        if (hipOccupancyMaxActiveBlocksPerMultiprocessor(&per_cu, (const void*)fwd_megakernel, 512, LDS_BYTES) != hipSuccess || per_cu < 1) { fprintf(stderr, "kernel_launch: occupancy query says %d blocks per CU\n", per_cu); per_cu = 1; }
        (void)hipGetLastError();
        grid = cus * per_cu;
        if (grid % 16 != 0 || grid < 16) grid = (grid / 16) * 16 > 0 ? (grid / 16) * 16 : 16;
    }
    if (grid < 0) return;
    Args a{};
    for (int i = 0; i < 25; ++i) a.in[i] = (const float*)d_in[i];
    a.out = (float*)d_out; a.ws = (unsigned char*)d_ws;
#if !MK_MULTI
    if (hipMemsetAsync((char*)d_ws + WS_CTL, 0, CTL_ZERO_BYTES, stream) != hipSuccess) { fprintf(stderr, "kernel_launch: memset failed\n"); return; }
#endif
#if MK_MULTI
    for (int ph = 0; ph < NPH; ++ph) { a.ph_lo = ph; a.ph_hi = ph + 1; hipLaunchKernelGGL(fwd_megakernel, dim3(grid), dim3(512), LDS_BYTES, stream, a); }
#else
    a.ph_lo = 0; a.ph_hi = NPH;
    void* kargs[] = {&a};
    hipError_t e = hipLaunchCooperativeKernel((const void*)fwd_megakernel, dim3(grid), dim3(512), kargs, LDS_BYTES, stream);
    if (e != hipSuccess) fprintf(stderr, "cooperative launch failed: %s (grid %d)\n", hipGetErrorString(e), grid);
#endif
}
```
